# Optimizing an MI355X kernel written in HIP

```python
import jax, jax.numpy as jnp
from jax import lax
import numpy as np

D_MODEL = 1024
BATCH = 8
SEQ = 2048
DEPTH = 4
DEC_BATCH = 32
DEC_SEQ = 64
PAST_LEN = 1024

CHUNK = 64
HEAD_DIM = 64
N_HEADS = 8
KV_HEADS = 2
GROUP = N_HEADS // KV_HEADS
WINDOW = 128
WIN_CHUNKS = WINDOW // CHUNK
ATTN_WIDTH = N_HEADS * HEAD_DIM
KV_WIDTH = KV_HEADS * HEAD_DIM
CONV_DIM = 256
CONV_W = 3
MEM_HEADS = 4
MEM_WIDTH = MEM_HEADS * HEAD_DIM
N_MEM = 256
MIX_WIDTH = ATTN_WIDTH + CONV_DIM + MEM_WIDTH
SPLIT_IDX = [ATTN_WIDTH, ATTN_WIDTH + KV_WIDTH, ATTN_WIDTH + 2 * KV_WIDTH,
             ATTN_WIDTH + 2 * KV_WIDTH + CONV_DIM, ATTN_WIDTH + 2 * KV_WIDTH + 2 * CONV_DIM,
             ATTN_WIDTH + 2 * KV_WIDTH + 3 * CONV_DIM]
IN_WIDTH = ATTN_WIDTH + 2 * KV_WIDTH + 3 * CONV_DIM + MEM_WIDTH
D_FF = ((8 * D_MODEL // 3 + 255) // 256) * 256
EPS = 1e-6
ATTN_SCALE = HEAD_DIM ** -0.5
NEG = -1e30

kernel_name = "hymba_swa_sink_shortconv_memxattn_stream"


def rms_norm(x, g):
    xf = x.astype(jnp.float32)
    xf = xf * lax.rsqrt(jnp.mean(xf * xf, axis=-1, keepdims=True) + EPS)
    return xf.astype(x.dtype) * g


def sink_attention(q, k, v, sink, valid):
    s = jnp.einsum('bnqkgd,bnskd->bnkgqs', q.astype(jnp.float32), k.astype(jnp.float32)) * ATTN_SCALE
    s = jnp.where(valid[None, :, None, None, None, :], s, NEG)
    sl = sink.astype(jnp.float32).reshape(KV_HEADS, GROUP)[None, None, :, :, None, None]
    m = jnp.maximum(jnp.max(s, axis=-1, keepdims=True), sl)
    p = jnp.exp(s - m)
    p = p / (jnp.sum(p, axis=-1, keepdims=True) + jnp.exp(sl - m))
    return jnp.einsum('bnkgqs,bnskd->bnqkgd', p.astype(v.dtype), v)


def window_attention_prompt(q, k, v, sink):
    B, L = q.shape[0], q.shape[1]
    nc = L // CHUNK
    qb = q.reshape(B, nc, CHUNK, KV_HEADS, GROUP, HEAD_DIM)
    pad = ((0, 0), (WIN_CHUNKS, 0), (0, 0), (0, 0), (0, 0))
    kp = jnp.pad(k.reshape(B, nc, CHUNK, KV_HEADS, HEAD_DIM), pad)
    vp = jnp.pad(v.reshape(B, nc, CHUNK, KV_HEADS, HEAD_DIM), pad)
    kb = jnp.concatenate([kp[:, i:i + nc] for i in range(WIN_CHUNKS + 1)], axis=2)
    vb = jnp.concatenate([vp[:, i:i + nc] for i in range(WIN_CHUNKS + 1)], axis=2)
    key_block = jnp.arange((WIN_CHUNKS + 1) * CHUNK) // CHUNK
    valid = (jnp.arange(nc)[:, None] + key_block[None, :]) >= WIN_CHUNKS
    o = sink_attention(qb, kb, vb, sink, valid)
    return o.reshape(B, L, ATTN_WIDTH)


def window_attention_sample(q, k, v, sink, cache_k, cache_v):
    B, L = q.shape[0], q.shape[1]
    kk = jnp.concatenate([cache_k, k], axis=1)
    vv = jnp.concatenate([cache_v, v], axis=1)
    valid = jnp.ones((1, kk.shape[1]), dtype=bool)
    o = sink_attention(q.reshape(B, 1, L, KV_HEADS, GROUP, HEAD_DIM), kk[:, None], vv[:, None], sink, valid)
    return o.reshape(B, L, ATTN_WIDTH), kk[:, -WINDOW:], vv[:, -WINDOW:]


def causal_conv(u, state, w):
    L = u.shape[1]
    up = jnp.concatenate([state, u], axis=1)
    y = up[:, 0:L] * w[0]
    for i in range(1, CONV_W):
        y = y + up[:, i:i + L] * w[i]
    return y, up[:, -(CONV_W - 1):]


def memory_kv(mem, mem_norm_g, w_mem_kv, mk_norm_g):
    B = mem.shape[0]
    mk, mv = jnp.split(rms_norm(mem, mem_norm_g) @ w_mem_kv, 2, axis=-1)
    mk = rms_norm(mk.reshape(B, N_MEM, MEM_HEADS, HEAD_DIM), mk_norm_g)
    return mk, mv.reshape(B, N_MEM, MEM_HEADS, HEAD_DIM)


def memory_attention(mq, mk, mv):
    s = jnp.einsum('blhd,bmhd->bhlm', mq.astype(jnp.float32), mk.astype(jnp.float32)) * ATTN_SCALE
    p = jax.nn.softmax(s, axis=-1)
    o = jnp.einsum('bhlm,bmhd->blhd', p.astype(mv.dtype), mv)
    return o.reshape(mq.shape[0], mq.shape[1], MEM_WIDTH)


def layer(x, mem_k, mem_v, cache_k, cache_v, conv_state, attn_norm_g, w_in, q_norm_g, k_norm_g,
          sinks, conv_w, mq_norm_g, out_norm_g, w_out, ffn_norm_g, w_gate_up, w_down):
    B, L, _ = x.shape
    u = rms_norm(x, attn_norm_g) @ w_in
    q, k, v, cb, cc, cx, mq = jnp.split(u, SPLIT_IDX, axis=-1)
    q = rms_norm(q.reshape(B, L, N_HEADS, HEAD_DIM), q_norm_g)
    k = rms_norm(k.reshape(B, L, KV_HEADS, HEAD_DIM), k_norm_g)
    v = v.reshape(B, L, KV_HEADS, HEAD_DIM)
    if cache_k is None:
        a = window_attention_prompt(q, k, v, sinks)
        new_k, new_v = k[:, -WINDOW:], v[:, -WINDOW:]
        conv_state = jnp.zeros((B, CONV_W - 1, CONV_DIM), dtype=x.dtype)
    else:
        a, new_k, new_v = window_attention_sample(q, k, v, sinks, cache_k, cache_v)
    cy, new_conv = causal_conv(cc * cx, conv_state, conv_w)
    cy = cb * cy
    mq = rms_norm(mq.reshape(B, L, MEM_HEADS, HEAD_DIM), mq_norm_g)
    mo = memory_attention(mq, mem_k, mem_v)
    mix = jnp.concatenate([
        rms_norm(a, out_norm_g[:ATTN_WIDTH]),
        rms_norm(cy, out_norm_g[ATTN_WIDTH:ATTN_WIDTH + CONV_DIM]),
        rms_norm(mo, out_norm_g[ATTN_WIDTH + CONV_DIM:]),
    ], axis=-1)
    h = x + mix @ w_out
    gate, up = jnp.split(rms_norm(h, ffn_norm_g) @ w_gate_up, 2, axis=-1)
    y = h + (jax.nn.silu(gate) * up) @ w_down
    return y, new_k, new_v, new_conv


def setup_inputs(seed: int = 0) -> dict:
    key = jax.random.key(seed)
    ks = jax.random.split(key, 24)
    f32 = jnp.float32
    nrm = lambda k, shape, scale: jax.random.normal(k, shape, f32) * scale
    gain = lambda k, shape: 1.0 + 0.05 * jax.random.normal(k, shape, f32)
    win_rows = min(WINDOW, PAST_LEN)
    return {
        "x_prompt": nrm(ks[0], (BATCH, SEQ, D_MODEL), 1.0),
        "x_sample": nrm(ks[1], (DEC_BATCH, DEC_SEQ, D_MODEL), 1.0),
        "mem_prompt": nrm(ks[2], (BATCH, N_MEM, D_MODEL), 1.0),
        "cache_win_k": nrm(ks[3], (DEPTH, DEC_BATCH, win_rows, KV_HEADS, HEAD_DIM), 1.0),
        "cache_win_v": nrm(ks[4], (DEPTH, DEC_BATCH, win_rows, KV_HEADS, HEAD_DIM), 1.0),
        "cache_conv": nrm(ks[5], (DEPTH, DEC_BATCH, CONV_W - 1, CONV_DIM), 1.0),
        "cache_mem_k": nrm(ks[6], (DEPTH, DEC_BATCH, N_MEM, MEM_HEADS, HEAD_DIM), 1.0),
        "cache_mem_v": nrm(ks[7], (DEPTH, DEC_BATCH, N_MEM, MEM_HEADS, HEAD_DIM), 1.0),
        "attn_norm_g": gain(ks[8], (DEPTH, D_MODEL)),
        "w_in": nrm(ks[9], (DEPTH, D_MODEL, IN_WIDTH), D_MODEL ** -0.5),
        "q_norm_g": gain(ks[10], (DEPTH, HEAD_DIM)),
        "k_norm_g": gain(ks[11], (DEPTH, HEAD_DIM)),
        "sinks": nrm(ks[12], (DEPTH, N_HEADS), 0.5),
        "conv_w": nrm(ks[13], (DEPTH, CONV_W, CONV_DIM), CONV_W ** -0.5),
        "mem_norm_g": gain(ks[14], (DEPTH, D_MODEL)),
        "w_mem_kv": nrm(ks[15], (DEPTH, D_MODEL, 2 * MEM_WIDTH), D_MODEL ** -0.5),
        "mq_norm_g": gain(ks[16], (DEPTH, HEAD_DIM)),
        "mk_norm_g": gain(ks[17], (DEPTH, HEAD_DIM)),
        "out_norm_g": gain(ks[18], (DEPTH, MIX_WIDTH)),
        "w_out": nrm(ks[19], (DEPTH, MIX_WIDTH, D_MODEL), MIX_WIDTH ** -0.5),
        "ffn_norm_g": gain(ks[20], (DEPTH, D_MODEL)),
        "w_gate_up": nrm(ks[21], (DEPTH, D_MODEL, 2 * D_FF), D_MODEL ** -0.5),
        "w_down": nrm(ks[22], (DEPTH, D_FF, D_MODEL), D_FF ** -0.5),
    }


def reference(x_prompt, x_sample, mem_prompt, cache_win_k, cache_win_v, cache_conv, cache_mem_k,
              cache_mem_v, attn_norm_g, w_in, q_norm_g, k_norm_g, sinks, conv_w, mem_norm_g,
              w_mem_kv, mq_norm_g, mk_norm_g, out_norm_g, w_out, ffn_norm_g, w_gate_up, w_down):
    yp, ys = x_prompt, x_sample
    wk_p, wv_p, cv_p, mk_p_all, mv_p_all = [], [], [], [], []
    wk_s, wv_s, cv_s = [], [], []
    for l in range(DEPTH):
        lw = (attn_norm_g[l], w_in[l], q_norm_g[l], k_norm_g[l], sinks[l], conv_w[l],
              mq_norm_g[l], out_norm_g[l], w_out[l], ffn_norm_g[l], w_gate_up[l], w_down[l])
        mk_p, mv_p = memory_kv(mem_prompt, mem_norm_g[l], w_mem_kv[l], mk_norm_g[l])
        yp, k_p, v_p, c_p = layer(yp, mk_p, mv_p, None, None, None, *lw)
        wk_p.append(k_p); wv_p.append(v_p); cv_p.append(c_p)
        mk_p_all.append(mk_p); mv_p_all.append(mv_p)
        ys, k_s, v_s, c_s = layer(ys, cache_mem_k[l], cache_mem_v[l], cache_win_k[l], cache_win_v[l],
                                  cache_conv[l], *lw)
        wk_s.append(k_s); wv_s.append(v_s); cv_s.append(c_s)
    return (yp, ys,
            jnp.stack(wk_p), jnp.stack(wv_p), jnp.stack(cv_p),
            jnp.stack(mk_p_all), jnp.stack(mv_p_all),
            jnp.stack(wk_s), jnp.stack(wv_s), jnp.stack(cv_s))
```

```cpp
#include <hip/hip_runtime.h>
#include <hip/hip_cooperative_groups.h>
#include <cstdio>
#include <cstdint>
namespace cg = cooperative_groups;
#define GAS __attribute__((address_space(1)))
#define LAS __attribute__((address_space(3)))
constexpr int MT_ = 18432;
constexpr size_t MiB = 1u << 20;
constexpr size_t WS_CTL = 0, CTL_ZERO_BYTES = 1 * MiB;
constexpr size_t WS_WIN = 1 * MiB, WS_WOUT = WS_WIN + 14 * MiB, WS_WGU = WS_WOUT + 8 * MiB, WS_WDN = WS_WGU + 44 * MiB, WS_WMEM = WS_WDN + 22 * MiB;
constexpr size_t WS_AB = WS_WMEM + 4 * MiB, WS_MEMB = WS_AB + 36 * MiB, WS_MRS = WS_MEMB + 4 * MiB, WS_PS = WS_MRS + 1 * MiB;
constexpr size_t WS_MK = WS_PS + 2 * MiB, WS_MVT = WS_MK + 20 * MiB, WS_CWK = WS_MVT + 20 * MiB, WS_CWVT = WS_CWK + 4 * MiB, WS_VTG = WS_CWVT + 4 * MiB;
constexpr size_t WS_R1 = WS_VTG + 5 * MiB, WS_UB = WS_R1, WS_MIX = WS_R1 + 50 * MiB, WS_ACT = WS_R1, WS_END = WS_R1 + 100 * MiB;
static_assert((size_t)18432 * 1408 * 2 <= 50 * MiB && (size_t)18432 * 1024 * 2 <= 36 * MiB && (size_t)18432 * 2816 * 2 <= 100 * MiB && (size_t)128 * 18432 * 2 <= 5 * MiB, "ws map");
constexpr int CW_BAR = 4096;

constexpr size_t O_YP = 0, O_YS = 16777216, O_WKP = 18874368, O_WVP = 19398656, O_CVP = 19922944, O_MKP = 19939328, O_MVP = 22036480,
                 O_WKS = 24133632, O_WVS = 26230784, O_CVS = 28327936, O_END = 28393472;

constexpr size_t WS_GT = WS_MRS + 65536;
#define N_LAUNCH_MODE 1
#define USE_CG_SYNC 3
namespace pg8 {
#define PG8_LAS __attribute__((address_space(3)))
typedef unsigned short bf16_t;
typedef short bf16x8 __attribute__((ext_vector_type(8)));
typedef float f32x4 __attribute__((ext_vector_type(4)));
typedef unsigned u32x4 __attribute__((ext_vector_type(4)));
constexpr int BM = 256, BK = 64, HALF = 128, HTB = HALF * BK * 2  , STAGE_BYTES = 8 * HTB, NXCD = 8, WGM = 8;

__host__ __device__ __forceinline__ int lds_byte(int r, int c) { const int st = (r >> 4) * 2 + (c >> 5), rr = r & 15, cc = c & 31, ob = rr * 64 + cc * 2; return st * 1024 + (ob ^ (((ob >> 9) & 1) << 5)); }
__host__ __device__ __forceinline__ void stage_rc(int b, int& R, int& C) { const int st = b / 1024, sb = b % 1024, swz = sb ^ (((sb >> 9) & 1) << 5); R = (st >> 1) * 16 + swz / 64; C = (st & 1) * 32 + (swz % 64) / 2; }
__host__ __device__ __forceinline__ int perm32(int rho) { const int n = rho >> 4, i = rho & 15; return 8 * (i >> 2) + 4 * n + (i & 3); }

struct Unit { int pm, pn; };
struct Gemm { const bf16_t* A; const bf16_t* Bt; int M, N, K; };

struct StaticOrder {
    int nM, nN, nwg, G, c;
    __host__ __device__ void init(int M, int N, int G_, int c_) { nM = M / BM; nN = N / BM; nwg = nM * nN; G = G_; c = c_; }
    __host__ __device__ bool next(int i, Unit& u) const {
        const long L = (long)i * G + c; if (L >= nwg) return false;
        int wgid = (int)L; { const int q = nwg / NXCD, r = nwg % NXCD, xcd = wgid % NXCD, off = wgid / NXCD; wgid = (xcd < r ? xcd * (q + 1) : r * (q + 1) + (xcd - r) * q) + off; }
        const int nig = WGM * nN, gid = wgid / nig, fm = gid * WGM, gsz = (nM - fm) < WGM ? (nM - fm) : WGM;
        u.pm = fm + ((wgid % nig) % gsz); u.pn = (wgid % nig) / gsz; return true;
    }
    __device__ __forceinline__ void a_ready(const Unit&) const {}
    __device__ __forceinline__ void done(const Unit&) const {}
};

__device__ __forceinline__ unsigned cvt_pk_bf16(float lo, float hi) { unsigned r; asm volatile("v_cvt_pk_bf16_f32 %0, %1, %2" : "=v"(r) : "v"(lo), "v"(hi)); return r; }

typedef unsigned u32x2 __attribute__((ext_vector_type(2)));
constexpr int E_MT = 18432, E_MP = 16384, E_UBW = 1408;
constexpr float E_EPS = 1e-6f;
constexpr float E_C2 = 0.125f * 1.4426950408889634f;

__device__ __forceinline__ float quad_sum(float s) { s += __shfl_xor(s, 16); s += __shfl_xor(s, 32); return s; }
__device__ __forceinline__ float sum4(const f32x4 a) { return (a[0] + a[1]) + (a[2] + a[3]); }
__device__ __forceinline__ float sq4(const f32x4 a) { return (a[0] * a[0] + a[1] * a[1]) + (a[2] * a[2] + a[3] * a[3]); }
__device__ __forceinline__ float row_rstd(const float* ps_row) {
    const f32x4* p = (const f32x4*)ps_row; const f32x4 a = p[0], b = p[1], c = p[2], d = p[3];
    const float s = (sum4(a) + sum4(b)) + (sum4(c) + sum4(d));
    return 1.0f / sqrtf(s * (1.0f / 1024.0f) + E_EPS);
}
__device__ __forceinline__ u32x4 pack8(const f32x4 a, const f32x4 b) { u32x4 w; w.x = cvt_pk_bf16(a[0], a[1]); w.y = cvt_pk_bf16(a[2], a[3]); w.z = cvt_pk_bf16(b[0], b[1]); w.w = cvt_pk_bf16(b[2], b[3]); return w; }
__device__ __forceinline__ bf16_t f2bf1(float f) { return (bf16_t)(cvt_pk_bf16(f, 0.f) & 0xffffu); }


__device__ __forceinline__ PG8_LAS const float* stage_rstd(const float* PS, PG8_LAS unsigned char* lds, int pm) {
    int t = threadIdx.x; asm volatile("" : "+v"(t));
    PG8_LAS float* R = (PG8_LAS float*)(lds + 131072);
    if (t < 256) R[t] = row_rstd(PS + (size_t)(pm * BM + t) * 16);
    asm volatile("s_waitcnt lgkmcnt(0)" ::: "memory");
    __builtin_amdgcn_s_barrier();
    asm volatile("" ::: "memory");
    return R;
}
struct EpiIn {
    static constexpr bool PERM = true, AFTER_DRAIN = false;
    unsigned char* ws; float* out; PG8_LAS unsigned char* lds; int l, pad;
    __device__ __forceinline__ void operator()(const f32x4 (&acc)[2][2][4][2], const Unit& u, int wr, int wc, int fr, int fq) const {
        const int pn = u.pn;
        bf16_t* UB = (bf16_t*)(ws + WS_UB);
        PG8_LAS const float* R = stage_rstd((const float*)(ws + WS_PS), lds, u.pm);
        const bool is_s = (u.pm >= 64);
        if (pn <= 1 || pn == 6 || (pn == 2 && wc < 2)) {
            const float* g = (const float*)(ws + WS_GT) + l * 256 + ((pn <= 1) ? 0 : ((pn == 6) ? 128 : 64));
            const int colbase = (pn <= 1) ? (pn * 4 + wc) * 64 : ((pn == 6) ? 1152 + wc * 64 : 512 + wc * 64);
            const float sc = (pn == 2) ? 1.0f : E_C2;
            float* okp = out + O_WKP + (size_t)l * 131072; float* oks = out + O_WKS + (size_t)l * 524288;
            f32x4 gv[2][2];
#pragma unroll
            for (int bj = 0; bj < 2; ++bj) { gv[bj][0] = *(const f32x4*)(g + bj * 32 + 8 * fq); gv[bj][1] = *(const f32x4*)(g + bj * 32 + 8 * fq + 4); }
#pragma unroll
            for (int ai = 0; ai < 2; ++ai)
#pragma unroll
                for (int m = 0; m < 4; ++m) {
                    int row = u.pm * BM + ai * HALF + wr * 64 + m * 16 + fr;
                    asm volatile("" : "+v"(row));
                    const float rs = R[ai * HALF + wr * 64 + m * 16 + fr];
                    f32x4 v[2][2];
#pragma unroll
                    for (int bj = 0; bj < 2; ++bj)
#pragma unroll
                        for (int n = 0; n < 2; ++n) v[bj][n] = acc[ai][bj][m][n] * rs;
                    float ss = (sq4(v[0][0]) + sq4(v[0][1])) + (sq4(v[1][0]) + sq4(v[1][1]));
                    ss = quad_sum(ss);
                    const float hr = (1.0f / sqrtf(ss * (1.0f / 64.0f) + E_EPS)) * sc;
#pragma unroll
                    for (int bj = 0; bj < 2; ++bj) {
                        const int c0 = bj * 32 + 8 * fq;
                        const f32x4 o0 = v[bj][0] * hr * gv[bj][0], o1 = v[bj][1] * hr * gv[bj][1];
                        *(u32x4*)(UB + (size_t)row * E_UBW + colbase + c0) = pack8(o0, o1);
                        if (pn == 2) {
                            const int sb = (row - E_MP) >> 6, st = (row - E_MP) & 63, pb = row >> 11, pt = row & 2047;
                            if (is_s) { float* d = oks + ((size_t)(sb * 128 + 64 + st) * 128 + wc * 64 + c0); __builtin_nontemporal_store(o0, (f32x4*)d); __builtin_nontemporal_store(o1, (f32x4*)(d + 4)); }
                            else if (pt >= 1920) { float* d = okp + ((size_t)(pb * 128 + (pt - 1920)) * 128 + wc * 64 + c0); __builtin_nontemporal_store(o0, (f32x4*)d); __builtin_nontemporal_store(o1, (f32x4*)(d + 4)); }
                        }
                    }
                }
        } else if (pn == 2) {
            bf16_t* VTG = (bf16_t*)(ws + WS_VTG);
            float* ovp = out + O_WVP + (size_t)l * 131072; float* ovs = out + O_WVS + (size_t)l * 524288;
#pragma unroll
            for (int ai = 0; ai < 2; ++ai)
#pragma unroll
                for (int m = 0; m < 4; ++m) {
                    int row = u.pm * BM + ai * HALF + wr * 64 + m * 16 + fr;
                    asm volatile("" : "+v"(row));
                    const float rs = R[ai * HALF + wr * 64 + m * 16 + fr];
                    const int sb = (row - E_MP) >> 6, st = (row - E_MP) & 63, pb = row >> 11, pt = row & 2047;
#pragma unroll
                    for (int bj = 0; bj < 2; ++bj) {
                        const f32x4 v0 = acc[ai][bj][m][0] * rs, v1 = acc[ai][bj][m][1] * rs;
                        const int c0 = (wc - 2) * 64 + bj * 32 + 8 * fq;
                        bf16_t* vp = VTG + (size_t)c0 * E_MT + row;
#pragma unroll
                        for (int j = 0; j < 4; ++j) { vp[(size_t)j * E_MT] = f2bf1(v0[j]); vp[(size_t)(4 + j) * E_MT] = f2bf1(v1[j]); }
                        if (is_s) { float* d = ovs + ((size_t)(sb * 128 + 64 + st) * 128 + c0); __builtin_nontemporal_store(v0, (f32x4*)d); __builtin_nontemporal_store(v1, (f32x4*)(d + 4)); }
                        else if (pt >= 1920) { float* d = ovp + ((size_t)(pb * 128 + (pt - 1920)) * 128 + c0); __builtin_nontemporal_store(v0, (f32x4*)d); __builtin_nontemporal_store(v1, (f32x4*)(d + 4)); }
                    }
                }
        } else if (pn == 3) {
#pragma unroll
            for (int ai = 0; ai < 2; ++ai)
#pragma unroll
                for (int m = 0; m < 4; ++m) {
                    int row = u.pm * BM + ai * HALF + wr * 64 + m * 16 + fr;
                    asm volatile("" : "+v"(row));
                    const float rs = R[ai * HALF + wr * 64 + m * 16 + fr];
#pragma unroll
                    for (int bj = 0; bj < 2; ++bj)
                        *(u32x4*)(UB + (size_t)row * E_UBW + 640 + wc * 64 + bj * 32 + 8 * fq) = pack8(acc[ai][bj][m][0] * rs, acc[ai][bj][m][1] * rs);
                }
        } else {
            float* ocp = out + O_CVP + (size_t)l * 4096; float* ocs = out + O_CVS + (size_t)l * 16384;
#pragma unroll
            for (int ai = 0; ai < 2; ++ai)
#pragma unroll
                for (int m = 0; m < 4; ++m) {
                    int row = u.pm * BM + ai * HALF + wr * 64 + m * 16 + fr;
                    asm volatile("" : "+v"(row));
                    const float rs = R[ai * HALF + wr * 64 + m * 16 + fr];
                    const float rs2 = rs * rs;
                    const f32x4 p0 = acc[ai][0][m][0] * acc[ai][1][m][0] * rs2, p1 = acc[ai][0][m][1] * acc[ai][1][m][1] * rs2;
                    const int ch0 = (pn - 4) * 128 + wc * 32 + 8 * fq;
                    *(u32x4*)(UB + (size_t)row * E_UBW + 896 + ch0) = pack8(p0, p1);
                    const int sb = (row - E_MP) >> 6, st = (row - E_MP) & 63, pb = row >> 11, pt = row & 2047;
                    if (is_s) { if (st >= 62) { float* d = ocs + ((size_t)(sb * 2 + (st - 62)) * 256 + ch0); __builtin_nontemporal_store(p0, (f32x4*)d); __builtin_nontemporal_store(p1, (f32x4*)(d + 4)); } }
                    else if (pt >= 2046) { float* d = ocp + ((size_t)(pb * 2 + (pt - 2046)) * 256 + ch0); __builtin_nontemporal_store(p0, (f32x4*)d); __builtin_nontemporal_store(p1, (f32x4*)(d + 4)); }
                }
        }
    }
};

struct EpiMem {
    static constexpr bool PERM = true, AFTER_DRAIN = false;
    unsigned char* ws; float* out;
    __device__ __forceinline__ void operator()(const f32x4 (&acc)[2][2][4][2], const Unit& u, int wr, int wc, int fr, int fq) const {
        const int l = u.pn >> 1, kind = u.pn & 1, b = u.pm;
        const float* MRS = (const float*)(ws + WS_MRS);
        if (kind == 0) {
            bf16_t* MK = (bf16_t*)(ws + WS_MK); float* o_mk = out + O_MKP;
            const float* g = (const float*)(ws + WS_GT) + l * 256 + 192;
#pragma unroll
            for (int ai = 0; ai < 2; ++ai)
#pragma unroll
                for (int m = 0; m < 4; ++m) {
                    int mrow = ai * HALF + wr * 64 + m * 16 + fr;
                    asm volatile("" : "+v"(mrow));
                    const float rs = MRS[b * 256 + mrow];
                    f32x4 v[2][2];
#pragma unroll
                    for (int bj = 0; bj < 2; ++bj)
#pragma unroll
                        for (int n = 0; n < 2; ++n) v[bj][n] = acc[ai][bj][m][n] * rs;
                    float ss = (sq4(v[0][0]) + sq4(v[0][1])) + (sq4(v[1][0]) + sq4(v[1][1]));
                    ss = quad_sum(ss);
                    const float hr = 1.0f / sqrtf(ss * (1.0f / 64.0f) + E_EPS);
#pragma unroll
                    for (int bj = 0; bj < 2; ++bj) {
                        const int c0 = bj * 32 + 8 * fq;
                        const f32x4 g0 = *(const f32x4*)(g + c0), g1 = *(const f32x4*)(g + c0 + 4);
                        const f32x4 o0 = v[bj][0] * hr * g0, o1 = v[bj][1] * hr * g1;
                        *(u32x4*)(MK + ((size_t)(l * 40 + b) * 256 + mrow) * 256 + wc * 64 + c0) = pack8(o0, o1);
                        float* d = o_mk + ((size_t)(l * 8 + b) * 256 + mrow) * 256 + wc * 64 + c0; __builtin_nontemporal_store(o0, (f32x4*)d); __builtin_nontemporal_store(o1, (f32x4*)(d + 4));
                    }
                }
        } else {
            bf16_t* MVT = (bf16_t*)(ws + WS_MVT); float* o_mv = out + O_MVP;
#pragma unroll
            for (int ai = 0; ai < 2; ++ai)
#pragma unroll
                for (int m = 0; m < 4; ++m) {
                    int mrow = ai * HALF + wr * 64 + m * 16 + fr;
                    asm volatile("" : "+v"(mrow));
                    const float rs = MRS[b * 256 + mrow];
#pragma unroll
                    for (int bj = 0; bj < 2; ++bj) {
                        const f32x4 v0 = acc[ai][bj][m][0] * rs, v1 = acc[ai][bj][m][1] * rs;
                        const int c0 = wc * 64 + bj * 32 + 8 * fq;
                        bf16_t* vp = MVT + ((size_t)(l * 40 + b) * 256 + c0) * 256 + mrow;
#pragma unroll
                        for (int j = 0; j < 4; ++j) { vp[j * 256] = f2bf1(v0[j]); vp[(4 + j) * 256] = f2bf1(v1[j]); }
                        float* d = o_mv + ((size_t)(l * 8 + b) * 256 + mrow) * 256 + c0; __builtin_nontemporal_store(v0, (f32x4*)d); __builtin_nontemporal_store(v1, (f32x4*)(d + 4));
                    }
                }
        }
    }
};

struct EpiRes {
    static constexpr bool PERM = true, AFTER_DRAIN = false;
    const float* base_p; const float* base_s; float* out; unsigned char* ws; int last, pad;
    __device__ __forceinline__ void operator()(const f32x4 (&acc)[2][2][4][2], const Unit& u, int wr, int wc, int fr, int fq) const {
        bf16_t* AB = (bf16_t*)(ws + WS_AB); float* PS = (float*)(ws + WS_PS);
        const int col0 = u.pn * BM + wc * 32 + 8 * fq;
#pragma unroll
        for (int ai = 0; ai < 2; ++ai) {
            f32x4 bv[4][2][2];
#pragma unroll
            for (int m = 0; m < 4; ++m) {
                const int row = u.pm * BM + ai * HALF + wr * 64 + m * 16 + fr;
                const float* bp = (u.pm < 64) ? base_p + (size_t)row * 1024 : base_s + (size_t)(row - E_MP) * 1024;
#pragma unroll
                for (int bj = 0; bj < 2; ++bj) { bv[m][bj][0] = *(const f32x4*)(bp + col0 + bj * HALF); bv[m][bj][1] = *(const f32x4*)(bp + col0 + bj * HALF + 4); }
            }
#pragma unroll
            for (int m = 0; m < 4; ++m) {
                const int row = u.pm * BM + ai * HALF + wr * 64 + m * 16 + fr;
                float ss = 0.f;
#pragma unroll
                for (int bj = 0; bj < 2; ++bj) {
                    const int c = col0 + bj * HALF;
                    const f32x4 y0 = bv[m][bj][0] + acc[ai][bj][m][0], y1 = bv[m][bj][1] + acc[ai][bj][m][1];
                    float* d = out + (size_t)row * 1024 + c;
                    if (last) { __builtin_nontemporal_store(y0, (f32x4*)d); __builtin_nontemporal_store(y1, (f32x4*)(d + 4)); }
                    else { *(f32x4*)d = y0; *(f32x4*)(d + 4) = y1; *(u32x4*)(AB + (size_t)row * 1024 + c) = pack8(y0, y1); ss += sq4(y0) + sq4(y1); }
                }
                if (!last) { ss = quad_sum(ss); if (fq == 0) PS[(size_t)row * 16 + u.pn * 4 + wc] = ss; }
            }
        }
    }
};

struct EpiGU {
    static constexpr bool PERM = true, AFTER_DRAIN = false;
    unsigned char* ws; PG8_LAS unsigned char* lds;
    __device__ __forceinline__ void operator()(const f32x4 (&acc)[2][2][4][2], const Unit& u, int wr, int wc, int fr, int fq) const {
        PG8_LAS const float* R = stage_rstd((const float*)(ws + WS_PS), lds, u.pm);
#pragma unroll
        for (int ai = 0; ai < 2; ++ai)
#pragma unroll
            for (int m = 0; m < 4; ++m) {
                const int row = u.pm * BM + ai * HALF + wr * 64 + m * 16 + fr;
                const float rs = R[ai * HALF + wr * 64 + m * 16 + fr];
                bf16_t* ACT = (bf16_t*)(ws + WS_ACT);
                f32x4 a[2];
#pragma unroll
                for (int n = 0; n < 2; ++n) {
                    const f32x4 g = acc[ai][0][m][n] * rs, uu = acc[ai][1][m][n] * rs;
#pragma unroll
                    for (int j = 0; j < 4; ++j) a[n][j] = g[j] * __builtin_amdgcn_rcpf(1.0f + __builtin_amdgcn_exp2f(-1.4426950408889634f * g[j])) * uu[j];
                }
                *(u32x4*)(ACT + (size_t)row * 2816 + u.pn * 128 + wc * 32 + 8 * fq) = pack8(a[0], a[1]);
            }
    }
};


template <class Epi, class Sched, bool ALIGN_EPI = false, bool SP2 = false>
__device__ __forceinline__ void gemm_phase(PG8_LAS unsigned char* lds, const Gemm g, const Sched& S, const Epi& E) {
    int tid_ = threadIdx.x; asm volatile("" : "+v"(tid_));
    const int tid = tid_, wid = __builtin_amdgcn_readfirstlane(tid >> 6), lane = tid & 63, wr = wid >> 2, wc = wid & 3, fr = lane & 15, fq = lane >> 4;
    const int K = g.K, nt = K / BK;
    unsigned voffA[2], voffB[2];
#pragma unroll
    for (int i = 0; i < 2; ++i) { int R, C; stage_rc(tid * 16 + i * 8192, R, C); const int Rb = Epi::PERM ? ((R & ~31) + perm32(R & 31)) : R;
        voffA[i] = (unsigned)(R * K + C) * 2u; voffB[i] = (unsigned)(Rb * K + C) * 2u; }
    const size_t kstep = (size_t)(BK * 2);
    const size_t hstep = (size_t)HALF * K * 2;
    const size_t tstep = 2 * hstep;
    const unsigned ldsw = (unsigned)wid * 1024u;
    const int aoff = lds_byte(wr * 64 + fr, fq * 8), boff = lds_byte(wc * 32 + fr, fq * 8);
#define PG8_SA(b, h) (((b) * 2 + (h)) * HTB)
#define PG8_SB(b, h) ((4 + (b) * 2 + (h)) * HTB)
#define PG8_STAGE(bufoff, gbase, voff) do { _Pragma("unroll") for (int _i = 0; _i < 2; ++_i) \
        __builtin_amdgcn_global_load_lds((const unsigned*)((const char*)(gbase) + (voff)[_i]), (PG8_LAS unsigned*)(lds + (bufoff) + ldsw + _i * 8192), 16, 0, 0); } while (0)
#define PG8_LDA(dst, b, h) do { _Pragma("unroll") for (int m = 0; m < 4; ++m) _Pragma("unroll") for (int k = 0; k < 2; ++k) dst[m][k] = *(const PG8_LAS bf16x8*)(lds + PG8_SA(b, h) + aoff + m * 2048 + k * 1024); } while (0)
#define PG8_LDB(dst, b, h) do { _Pragma("unroll") for (int n = 0; n < 2; ++n) _Pragma("unroll") for (int k = 0; k < 2; ++k) dst[n][k] = *(const PG8_LAS bf16x8*)(lds + PG8_SB(b, h) + boff + n * 2048 + k * 1024); } while (0)
#define PG8_MMA(ai, bj, At, Bt) do { __builtin_amdgcn_s_setprio(1); _Pragma("unroll") for (int m = 0; m < 4; ++m) _Pragma("unroll") for (int n = 0; n < 2; ++n) _Pragma("unroll") for (int k = 0; k < 2; ++k) \
        acc[ai][bj][m][n] = __builtin_amdgcn_mfma_f32_16x16x32_bf16(Bt[n][k], At[m][k], acc[ai][bj][m][n], 0, 0, 0); __builtin_amdgcn_s_setprio(0); } while (0)
#define PG8_WAIT_V(n) asm volatile("s_waitcnt vmcnt(" #n ")" ::: "memory")
#define PG8_WAIT_L(n) asm volatile("s_waitcnt lgkmcnt(" #n ")" ::: "memory")
#define PG8_BAR __builtin_amdgcn_s_barrier()
#define PG8_SCHED __builtin_amdgcn_sched_barrier(0)
    Unit cur, nxt; int ui = 0;
    if (!S.next(0, cur)) return;
    f32x4 acc[2][2][4][2];
#pragma unroll
    for (int a = 0; a < 2; ++a)
#pragma unroll
        for (int b = 0; b < 2; ++b)
#pragma unroll
            for (int m = 0; m < 4; ++m)
#pragma unroll
                for (int n = 0; n < 2; ++n) acc[a][b][m][n] = (f32x4){0.f, 0.f, 0.f, 0.f};
    bf16x8 At[4][2], B0[2][2], B1[2][2];
    const char* cA = (const char*)g.A + (size_t)cur.pm * tstep; const char* cB = (const char*)g.Bt + (size_t)cur.pn * tstep;
    S.a_ready(cur);
    if constexpr (SP2) {
        PG8_STAGE(PG8_SB(0, 0), cB, voffB); PG8_STAGE(PG8_SB(0, 1), cB + hstep, voffB); PG8_STAGE(PG8_SA(0, 0), cA, voffA); PG8_STAGE(PG8_SA(0, 1), cA + hstep, voffA);
        if (wr == 1) PG8_BAR;
        PG8_WAIT_V(2); PG8_BAR;
        PG8_STAGE(PG8_SB(1, 0), cB + kstep, voffB); PG8_STAGE(PG8_SA(1, 0), cA + kstep, voffA); PG8_STAGE(PG8_SB(1, 1), cB + hstep + kstep, voffB);
        PG8_WAIT_V(6); PG8_BAR;
    } else {
        PG8_STAGE(PG8_SB(0, 0), cB, voffB); PG8_STAGE(PG8_SA(0, 0), cA, voffA); PG8_STAGE(PG8_SB(0, 1), cB + hstep, voffB); PG8_STAGE(PG8_SA(0, 1), cA + hstep, voffA);
        if (wr == 1) PG8_BAR;
        PG8_WAIT_V(4); PG8_BAR;
        PG8_STAGE(PG8_SB(1, 0), cB + kstep, voffB); PG8_STAGE(PG8_SA(1, 0), cA + kstep, voffA); PG8_STAGE(PG8_SB(1, 1), cB + hstep + kstep, voffB);
        PG8_WAIT_V(6); PG8_BAR;
    }
    for (;;) {
        const bool has_next = S.next(ui + 1, nxt);
        const char* nA = has_next ? (const char*)g.A + (size_t)nxt.pm * tstep : cA; const char* nB = has_next ? (const char*)g.Bt + (size_t)nxt.pn * tstep : cB;
        for (int t = 0; t < nt; t += 2) {
            const bool last = (t == nt - 2);
            const char* a1 = cA + (size_t)(t + 1) * kstep;
            const char* a2 = last ? nA : cA + (size_t)(t + 2) * kstep; const char* b2 = last ? nB : cB + (size_t)(t + 2) * kstep;
            const char* a3 = a2 + kstep; const char* b3 = b2 + kstep;
            if (last && has_next) S.a_ready(nxt);
            if constexpr (SP2) {
            PG8_LDB(B0, 0, 0); PG8_LDB(B1, 0, 1); PG8_SCHED; PG8_LDA(At, 0, 0); PG8_STAGE(PG8_SA(1, 1), a1 + hstep, voffA);
            PG8_WAIT_V(8); PG8_WAIT_L(0); PG8_BAR; PG8_MMA(0, 0, At, B0); PG8_MMA(0, 1, At, B1); PG8_BAR; PG8_SCHED;
            PG8_LDA(At, 0, 1); PG8_STAGE(PG8_SB(0, 0), b2, voffB); PG8_STAGE(PG8_SB(0, 1), b2 + hstep, voffB); PG8_STAGE(PG8_SA(0, 0), a2, voffA);
            PG8_WAIT_V(8); PG8_WAIT_L(0); PG8_BAR; PG8_MMA(1, 0, At, B0); PG8_MMA(1, 1, At, B1); PG8_BAR; PG8_SCHED;
            PG8_LDB(B0, 1, 0); PG8_LDB(B1, 1, 1); PG8_SCHED; PG8_LDA(At, 1, 0); PG8_STAGE(PG8_SA(0, 1), a2 + hstep, voffA);
            PG8_WAIT_V(8); PG8_WAIT_L(0); PG8_BAR; PG8_MMA(0, 0, At, B0); PG8_MMA(0, 1, At, B1); PG8_BAR; PG8_SCHED;
            PG8_LDA(At, 1, 1); PG8_STAGE(PG8_SB(1, 0), b3, voffB); PG8_STAGE(PG8_SB(1, 1), b3 + hstep, voffB); PG8_STAGE(PG8_SA(1, 0), a3, voffA);
            PG8_WAIT_V(8); PG8_WAIT_L(0); PG8_BAR; PG8_MMA(1, 0, At, B0); PG8_MMA(1, 1, At, B1); PG8_BAR; PG8_SCHED;
            } else {
            PG8_LDB(B0, 0, 0); PG8_SCHED; PG8_LDA(At, 0, 0); PG8_STAGE(PG8_SA(1, 1), a1 + hstep, voffA);
            PG8_WAIT_L(8); PG8_BAR; PG8_WAIT_L(0); PG8_MMA(0, 0, At, B0); PG8_BAR; PG8_SCHED;
            PG8_LDB(B1, 0, 1); PG8_STAGE(PG8_SB(0, 0), b2, voffB);
            PG8_BAR; PG8_WAIT_L(0); PG8_MMA(0, 1, At, B1); PG8_BAR;
            PG8_LDA(At, 0, 1); PG8_STAGE(PG8_SA(0, 0), a2, voffA);
            PG8_BAR; PG8_WAIT_L(0); PG8_MMA(1, 0, At, B0); PG8_BAR; PG8_SCHED;
            PG8_STAGE(PG8_SB(0, 1), b2 + hstep, voffB);
            PG8_WAIT_V(6); PG8_BAR; PG8_MMA(1, 1, At, B1); PG8_BAR;
            PG8_LDB(B0, 1, 0); PG8_SCHED; PG8_LDA(At, 1, 0); PG8_STAGE(PG8_SA(0, 1), a2 + hstep, voffA);
            PG8_WAIT_L(8); PG8_BAR; PG8_WAIT_L(0); PG8_MMA(0, 0, At, B0); PG8_BAR; PG8_SCHED;
            PG8_LDB(B1, 1, 1); PG8_STAGE(PG8_SB(1, 0), b3, voffB);
            PG8_BAR; PG8_WAIT_L(0); PG8_MMA(0, 1, At, B1); PG8_BAR;
            PG8_LDA(At, 1, 1); PG8_STAGE(PG8_SA(1, 0), a3, voffA);
            PG8_BAR; PG8_WAIT_L(0); PG8_MMA(1, 0, At, B0); PG8_BAR; PG8_SCHED;
            PG8_STAGE(PG8_SB(1, 1), b3 + hstep, voffB);
            PG8_WAIT_V(6); PG8_BAR; PG8_MMA(1, 1, At, B1); PG8_BAR;
            }
        }
        if constexpr (ALIGN_EPI) { if (wr == 0) PG8_BAR; }
        if constexpr (!Epi::AFTER_DRAIN) { E(acc, cur, wr, wc, fr, fq); S.done(cur); }
        if (!has_next) break;
#pragma unroll
        for (int a = 0; a < 2; ++a)
#pragma unroll
            for (int b = 0; b < 2; ++b)
#pragma unroll
                for (int m = 0; m < 4; ++m)
#pragma unroll
                    for (int n = 0; n < 2; ++n) acc[a][b][m][n] = (f32x4){0.f, 0.f, 0.f, 0.f};
        cur = nxt; cA = nA; cB = nB; ++ui;
        if constexpr (ALIGN_EPI) { if (wr == 1) PG8_BAR; }
    }
    PG8_WAIT_V(0);
    if constexpr (!ALIGN_EPI) { if (wr == 0) PG8_BAR; }
    PG8_BAR;
    if constexpr (Epi::AFTER_DRAIN) { E.fused(acc, cur, wr, wc, fr, fq, lds, wid, lane); S.done(cur); }
#undef PG8_SA
#undef PG8_SB
#undef PG8_STAGE
#undef PG8_LDA
#undef PG8_LDB
#undef PG8_MMA
#undef PG8_WAIT_V
#undef PG8_WAIT_L
#undef PG8_BAR
#undef PG8_SCHED
}
}
typedef unsigned short bf16;
#define XB_TMO      128
#define XB_XCNT(j)  (256  + 64 * (j))
#define XB_XSUB(j)  (1280 + 64 * (j))
#define XB_XGEN(j)  (2304 + 64 * (j))
#define XB_TOP      3328
#define XB_TOPGEN   3392
#define XCD_BAR_WORDS 3456
#define XB_SPIN_CAP (1u << 18)

__device__ __forceinline__ unsigned xb_ld(unsigned* p)              { return __hip_atomic_load(p, __ATOMIC_RELAXED, __HIP_MEMORY_SCOPE_AGENT); }
__device__ __forceinline__ unsigned xb_add(unsigned* p, unsigned v) { return __hip_atomic_fetch_add(p, v, __ATOMIC_RELAXED, __HIP_MEMORY_SCOPE_AGENT); }
__device__ __forceinline__ unsigned xb_xcc_id() { return (unsigned)__builtin_amdgcn_s_getreg((3 << 11) | 20) & 0xFu; }
#define XB_SPIN(cond, bar) do { unsigned _sp = 0; while (cond) { __builtin_amdgcn_s_sleep(1); \
    if ((++_sp & 255u) == 0u) { if (xb_ld(&(bar)[XB_TMO])) break; if (_sp > XB_SPIN_CAP) { atomicAdd(&(bar)[XB_TMO], 1u); break; } } } } while (0)

struct XcdBarrier {
    unsigned* bar; unsigned x;
    volatile LAS unsigned* st;
};

__device__ __forceinline__ XcdBarrier xcd_barrier_post(unsigned* bar, volatile LAS unsigned* st) {
    XcdBarrier b; b.bar = bar; b.x = xb_xcc_id(); b.st = st;
    if (threadIdx.x == 0) (void)xb_add(&bar[XB_XCNT(b.x)], 1u);
    return b;
}
__device__ __forceinline__ void xcd_barrier_complete(unsigned* bar, unsigned x, unsigned& nloc, unsigned& nx) {
    const unsigned G = gridDim.x * gridDim.y * gridDim.z;
    unsigned sum, cnt, mine, sp = 0u;
    for (;;) {
        sum = 0u; cnt = 0u; mine = 0u;
#pragma unroll
        for (unsigned j = 0; j < 16; ++j) { const unsigned c = xb_ld(&bar[XB_XCNT(j)]); sum += c; cnt += (c > 0u) ? 1u : 0u; mine = (j == x) ? c : mine; }
        if (sum == G) break;
        __builtin_amdgcn_s_sleep(1);
        if ((++sp & 255u) == 0u) { if (xb_ld(&bar[XB_TMO])) break; if (sp > XB_SPIN_CAP) { atomicAdd(&bar[XB_TMO], 1u); break; } }
    }
    nloc = mine > 0u ? mine : 1u; nx = cnt > 0u ? cnt : 1u;
}

__device__ __forceinline__ void xcd_barrier(const XcdBarrier& b) {
    asm volatile("s_waitcnt vmcnt(0)" ::: "memory");
    __syncthreads();
    if (threadIdx.x == 0) {
        unsigned* bar = b.bar;
        __builtin_amdgcn_s_waitcnt(0);
        unsigned nloc = b.st[0], nx = b.st[1];
        if (nloc == 0u) { xcd_barrier_complete(bar, b.x, nloc, nx); b.st[0] = nloc; b.st[1] = nx; }
        const unsigned old = xb_add(&bar[XB_XSUB(b.x)], 1u);
        const unsigned gen = old / nloc;
        if (old + 1u == (gen + 1u) * nloc) {
            __builtin_amdgcn_fence(__ATOMIC_RELEASE, "agent");
            asm volatile("s_waitcnt vmcnt(0)" ::: "memory");
            const unsigned og = xb_add(&bar[XB_TOP], 1u);
            const unsigned tg = og / nx;
            if (og + 1u == (tg + 1u) * nx) xb_add(&bar[XB_TOPGEN], 1u);
            else XB_SPIN(xb_ld(&bar[XB_TOPGEN]) == tg, bar);
            __builtin_amdgcn_fence(__ATOMIC_ACQUIRE, "agent");
            xb_add(&bar[XB_XGEN(b.x)], 1u);
            asm volatile("s_waitcnt vmcnt(0)" ::: "memory");
        } else {
            XB_SPIN(xb_ld(&bar[XB_XGEN(b.x)]) == gen, bar);
            __builtin_amdgcn_fence(__ATOMIC_ACQUIRE, "agent");
            asm volatile("s_waitcnt vmcnt(0)" ::: "memory");
        }
    }
    __syncthreads();
}

#define GAS __attribute__((address_space(1)))
#define LAS __attribute__((address_space(3)))
typedef unsigned short bf16;
typedef unsigned v4u __attribute__((ext_vector_type(4)));
typedef unsigned v2u __attribute__((ext_vector_type(2)));
typedef float f32x4 __attribute__((ext_vector_type(4)));
typedef short bf16x8 __attribute__((ext_vector_type(8)));
#define LDS_WAIT() asm volatile("s_waitcnt lgkmcnt(0)" ::: "memory")

constexpr int NWAVES = 8;
constexpr int D = 1024, NBP = 8, SEQ = 2048, DEPTH = 4, NBS = 32, DSEQ = 64;
constexpr int MP = NBP * SEQ, MS = NBS * DSEQ, MT = MP + MS;
constexpr int INW = 1792, DFF = 2816, NMEM = 256, UBW = 1408;
constexpr float EPS = 1e-6f, LOG2E = 1.4426950408889634f;
constexpr int NPHASE = 21;
constexpr int NUNITS = MT / 64;

constexpr int A_KS = 0, A_VT1 = 55296, A_VT2 = 73728, A_RED = 141312, MISC_OFF = 143360, LDS_BYTES = 147456;

struct Args { const float* in[23]; float* out; unsigned char* ws; int ph_lo, ph_hi; };

__device__ __forceinline__ float wave_sum(float v) {
#pragma unroll
    for (int o = 1; o < 64; o <<= 1) v += __shfl_xor(v, o);
    return v;
}
__device__ __forceinline__ unsigned pk2(float lo, float hi) { return pg8::cvt_pk_bf16(lo, hi); }

__device__ __forceinline__ void p0_transpose_item(const float* W, int ldw, int K, const float* gain, bf16* WT, int n0src, int n0dst, int k0, LAS float* scr, int lane) {
#pragma unroll
    for (int i = 0; i < 32; ++i) {
        const int kk = 2 * i + (lane >> 5);
        float w = __builtin_nontemporal_load(&W[(size_t)(k0 + kk) * ldw + n0src + (lane & 31)]);
        if (gain) w *= gain[k0 + kk];
        scr[kk * 33 + (lane & 31)] = w;
    }
    LDS_WAIT(); asm volatile("" ::: "memory");
    const int c = lane & 7;
#pragma unroll
    for (int j = 0; j < 4; ++j) {
        const int n = (lane >> 3) + 8 * j; const LAS float* s = scr + (8 * c) * 33 + n;
        v4u o; o.x = pk2(s[0 * 33], s[1 * 33]); o.y = pk2(s[2 * 33], s[3 * 33]); o.z = pk2(s[4 * 33], s[5 * 33]); o.w = pk2(s[6 * 33], s[7 * 33]);
        *(v4u*)(WT + (size_t)(n0dst + n) * K + k0 + 8 * c) = o;
    }
    LDS_WAIT(); asm volatile("" ::: "memory");
}
__device__ __forceinline__ int perm_in(int nd) {
    const int pn = nd >> 8, p = nd & 255, bj = p >> 7, wc = (p >> 5) & 3, i = p & 31;
    if (pn == 4 || pn == 5) return (bj ? 1280 : 1024) + (pn - 4) * 128 + wc * 32 + i;
    return pn * 256 + wc * 64 + bj * 32 + i;
}
__device__ __forceinline__ int perm_gu(int nd) { const int pn = nd >> 8, p = nd & 255; return (p < 128) ? pn * 128 + p : DFF + pn * 128 + (p - 128); }
__device__ __forceinline__ int perm_mem(int nd) { const int pn = nd >> 8, p = nd & 255, bj = p >> 7, wc = (p >> 5) & 3, i = p & 31; return pn * 256 + wc * 64 + bj * 32 + i; }

__device__ __forceinline__ void convert_layer_weights(const Args& a, unsigned char* ws, LAS float* scr, int l, int gw, int NGW, int lane, int which) {
    constexpr int C_IN = 896, C_OUT = 512, C_GU = 2816, C_DN = 1408;
    const int n_in = (which & 1) ? C_IN : 0, n_out = (which & 2) ? C_OUT : 0, n_gu = (which & 4) ? C_GU : 0, n_dn = (which & 8) ? C_DN : 0;
    for (int it = gw; it < n_in + n_out + n_gu + n_dn; it += NGW) {
        int r = it;
        if (r < n_in) { const int kb = r / 56, nb = r % 56; p0_transpose_item(a.in[9] + (size_t)l * D * INW, INW, D, a.in[8] + l * D, (bf16*)(ws + WS_WIN) + (size_t)l * INW * D, perm_in(32 * nb), 32 * nb, 64 * kb, scr, lane); continue; } r -= n_in;
        if (r < n_out) { const int kb = r / 32, nb = r % 32; p0_transpose_item(a.in[19] + (size_t)l * D * D, D, D, a.in[18] + l * D, (bf16*)(ws + WS_WOUT) + (size_t)l * D * D, 32 * nb, 32 * nb, 64 * kb, scr, lane); continue; } r -= n_out;
        if (r < n_gu) { const int kb = r / 176, nb = r % 176; p0_transpose_item(a.in[21] + (size_t)l * D * 2 * DFF, 2 * DFF, D, a.in[20] + l * D, (bf16*)(ws + WS_WGU) + (size_t)l * 2 * DFF * D, perm_gu(32 * nb), 32 * nb, 64 * kb, scr, lane); continue; } r -= n_gu;
        { const int kb = r / 32, nb = r % 32; p0_transpose_item(a.in[22] + (size_t)l * DFF * D, D, DFF, nullptr, (bf16*)(ws + WS_WDN) + (size_t)l * D * DFF, 32 * nb, 32 * nb, 64 * kb, scr, lane); }
    }
}
__device__ __forceinline__ void convert_layer_caches(const Args& a, unsigned char* ws, LAS float* scr, int l, int gw, int NGW, int gt, int NGT, int lane) {
    constexpr int C_CMV = 1024, C_CWV = 256;
    for (int it = gw; it < C_CMV + C_CWV; it += NGW) {
        int r = it;
        if (r < C_CMV) { const int b = r / 32, r2 = r % 32, kb = r2 / 8, nb = r2 % 8; p0_transpose_item(a.in[7] + (size_t)(l * NBS + b) * 65536, 256, 256, nullptr, (bf16*)(ws + WS_MVT) + (size_t)(l * 40 + 8 + b) * 65536, 32 * nb, 32 * nb, 64 * kb, scr, lane); continue; } r -= C_CMV;
        { const int b = r / 8, r2 = r % 8, kb = r2 / 4, nb = r2 % 4; p0_transpose_item(a.in[4] + (size_t)(l * NBS + b) * 16384, 128, 128, nullptr, (bf16*)(ws + WS_CWVT) + (size_t)(l * NBS + b) * 16384, 32 * nb, 32 * nb, 64 * kb, scr, lane); }
    }
    for (int i = gt; i < (524288 + 2097152) / 8; i += NGT) {
        const float* src; bf16* dst;
        if (i < 65536) { const size_t e = (size_t)l * 524288 + (size_t)i * 8; src = a.in[3] + e; dst = (bf16*)(ws + WS_CWK) + e; }
        else { const int e = (i - 65536) * 8, b = e >> 16, rem = e & 65535; src = a.in[6] + (size_t)(l * NBS + b) * 65536 + rem; dst = (bf16*)(ws + WS_MK) + (size_t)(l * 40 + 8 + b) * 65536 + rem; }
        const f32x4 x0 = __builtin_nontemporal_load((const f32x4*)src), x1 = __builtin_nontemporal_load((const f32x4*)(src + 4));
        v4u o; o.x = pk2(x0.x, x0.y); o.y = pk2(x0.z, x0.w); o.z = pk2(x1.x, x1.y); o.w = pk2(x1.z, x1.w);
        *(v4u*)dst = o;
    }
}
__device__ __forceinline__ void p0_prologue(const Args& a, unsigned char* ws, LAS unsigned char* lds, int tid_in, int lane_in, int wave) {
    int tid = tid_in, lane = lane_in; asm volatile("" : "+v"(tid), "+v"(lane));
    LAS float* scr = (LAS float*)(lds + wave * 16384);
    const int G = gridDim.x, gw = blockIdx.x * NWAVES + wave, NGW = G * NWAVES;
    convert_layer_weights(a, ws, scr, 0, gw, NGW, lane, 1);
    for (int it = gw; it < DEPTH * 256; it += NGW) {
        const int l = it >> 8, r = it & 255, kb = r / 16, nb = r % 16;
        p0_transpose_item(a.in[15] + (size_t)l * D * 512, 512, D, a.in[14] + l * D, (bf16*)(ws + WS_WMEM) + (size_t)l * 512 * D, perm_mem(32 * nb), 32 * nb, 64 * kb, scr, lane);
    }
    convert_layer_caches(a, ws, scr, 0, gw, NGW, blockIdx.x * (NWAVES * 64) + tid, G * NWAVES * 64, lane);
    for (int m0 = 2 * gw; m0 < MT + NBP * NMEM; m0 += 2 * NGW) {
        f32x4 v[2][4]; float s[2];
#pragma unroll
        for (int q = 0; q < 2; ++q) {
            const int m = m0 + q;
            const float* src = (m < MP) ? a.in[0] + (size_t)m * D : (m < MT ? a.in[1] + (size_t)(m - MP) * D : a.in[2] + (size_t)(m - MT) * D);
            const f32x4* xr = (const f32x4*)src + lane;
#pragma unroll
            for (int j = 0; j < 4; ++j) v[q][j] = __builtin_nontemporal_load(&xr[64 * j]);
        }
#pragma unroll
        for (int q = 0; q < 2; ++q) {
            const int m = m0 + q;
            bf16* dst = (m < MT) ? (bf16*)(ws + WS_AB) + (size_t)m * D : (bf16*)(ws + WS_MEMB) + (size_t)(m - MT) * D;
            float sq = 0.f;
#pragma unroll
            for (int j = 0; j < 4; ++j) sq += (v[q][j].x * v[q][j].x + v[q][j].y * v[q][j].y) + (v[q][j].z * v[q][j].z + v[q][j].w * v[q][j].w);
            s[q] = wave_sum(sq);
            v2u* o8 = (v2u*)dst + lane;
#pragma unroll
            for (int j = 0; j < 4; ++j) { v2u o; o.x = pk2(v[q][j].x, v[q][j].y); o.y = pk2(v[q][j].z, v[q][j].w); o8[64 * j] = o; }
            if (m < MT) { if (lane < 16) ((float*)(ws + WS_PS))[(size_t)m * 16 + lane] = (lane == 0) ? s[q] : 0.f; }
            else if (lane == 0) ((float*)(ws + WS_MRS))[m - MT] = 1.0f / sqrtf(s[q] * (1.0f / D) + EPS);
        }
    }
    if (blockIdx.x == 0) for (int i = tid; i < DEPTH * 256; i += NWAVES * 64) {
        const int l = i >> 8, k = (i >> 6) & 3, j = i & 63;
        const float* gp = (k == 0) ? a.in[10] : ((k == 1) ? a.in[11] : ((k == 2) ? a.in[16] : a.in[17]));
        ((float*)(ws + WS_GT))[i] = gp[l * 64 + j];
    }
    const int gt = blockIdx.x * (NWAVES * 64) + tid, NGT = G * NWAVES * 64;
}
__device__ __forceinline__ void copy_window_outputs(const Args& a, int gt, int NGT) {
    for (int i = gt; i < 2 * 128 * 2048; i += NGT) {
        const int t = i >> 18, r = i & 262143, lb = r >> 11, q = r & 2047;
        const float* src = (t ? a.in[4] : a.in[3]) + (size_t)lb * 16384 + 8192 + q * 4;
        float* dst = a.out + (t ? O_WVS : O_WKS) + (size_t)lb * 16384 + q * 4;
        __builtin_nontemporal_store(__builtin_nontemporal_load((const f32x4*)src), (f32x4*)dst);
    }
}

__device__ __forceinline__ f32x4 mfma16(bf16x8 a, bf16x8 b, f32x4 c) { return __builtin_amdgcn_mfma_f32_16x16x32_bf16(a, b, c, 0, 0, 0); }

template <int NKT, int VSTR, bool SINK>
__device__ __forceinline__ void attn_core(LAS const unsigned char* kb_, LAS const unsigned char* vb_, bf16x8 q0, bf16x8 q1, float sk, unsigned mskbits, int fr, f32x4 (&o)[4]) {
    f32x4 S[NKT];
    const int krow = ((fr >> 2) << 3) + (fr & 3);
#pragma unroll
    for (int kt = 0; kt < NKT; ++kt) {
        const int key = (kt >> 1) * 32 + ((kt & 1) << 2) + krow;
        LAS const unsigned char* kp = kb_ + key * 144;
        const bf16x8 a0 = *(LAS const bf16x8*)kp, a1 = *(LAS const bf16x8*)(kp + 64);
        const float bias = ((mskbits >> (kt >> 2)) & 1u) ? -1e30f : 0.f;
        f32x4 s = mfma16(a0, q0, (f32x4){bias, bias, bias, bias});
        s = mfma16(a1, q1, s);
        S[kt] = s;
    }
    float mx = S[0][0];
#pragma unroll
    for (int kt = 0; kt < NKT; ++kt) mx = fmaxf(fmaxf(mx, fmaxf(S[kt][0], S[kt][1])), fmaxf(S[kt][2], S[kt][3]));
    mx = fmaxf(mx, __shfl_xor(mx, 16)); mx = fmaxf(mx, __shfl_xor(mx, 32));
    if (SINK) mx = fmaxf(mx, sk);
    float sum = 0.f;
#pragma unroll
    for (int kt = 0; kt < NKT; ++kt)
#pragma unroll
        for (int r = 0; r < 4; ++r) { const float p = __builtin_amdgcn_exp2f(S[kt][r] - mx); S[kt][r] = p; sum += p; }
    sum += __shfl_xor(sum, 16); sum += __shfl_xor(sum, 32);
    if (SINK) sum += __builtin_amdgcn_exp2f(sk - mx);
    const float inv = 1.0f / sum;
    bf16x8 pf[NKT / 2];
#pragma unroll
    for (int kb = 0; kb < NKT / 2; ++kb) {
        v4u w; w.x = pk2(S[2 * kb][0], S[2 * kb][1]); w.y = pk2(S[2 * kb][2], S[2 * kb][3]); w.z = pk2(S[2 * kb + 1][0], S[2 * kb + 1][1]); w.w = pk2(S[2 * kb + 1][2], S[2 * kb + 1][3]);
        pf[kb] = __builtin_bit_cast(bf16x8, w);
    }
#pragma unroll
    for (int dt = 0; dt < 4; ++dt) {
        f32x4 acc = (f32x4){0.f, 0.f, 0.f, 0.f};
#pragma unroll
        for (int kb = 0; kb < NKT / 2; ++kb) {
            const bf16x8 vf = *(LAS const bf16x8*)(vb_ + dt * 16 * VSTR + kb * 64);
            acc = mfma16(vf, pf[kb], acc);
        }
        o[dt] = acc * inv;
    }
}
__device__ __forceinline__ void unpack8(const v4u w, float (&f)[8]) {
    f[0] = __uint_as_float(w.x << 16); f[1] = __uint_as_float(w.x & 0xffff0000u); f[2] = __uint_as_float(w.y << 16); f[3] = __uint_as_float(w.y & 0xffff0000u);
    f[4] = __uint_as_float(w.z << 16); f[5] = __uint_as_float(w.z & 0xffff0000u); f[6] = __uint_as_float(w.w << 16); f[7] = __uint_as_float(w.w & 0xffff0000u);
}

template <bool DO_SWA, bool DO_MEM>
__device__ __forceinline__ void attn_unit(const Args& a, unsigned char* ws, LAS unsigned char* lds, int l, int tid_in, int lane_in, int wave, int unit) {
    const bf16* UB = (const bf16*)(ws + WS_UB); const bf16* VTG = (const bf16*)(ws + WS_VTG);
    const bf16* CWK = (const bf16*)(ws + WS_CWK); const bf16* CWVT = (const bf16*)(ws + WS_CWVT);
    bf16* MIX = (bf16*)(ws + WS_MIX);
    const int qs = wave & 3, g = wave >> 2;
    LAS float* red_a = (LAS float*)(lds + A_RED); LAS float* red_m = red_a + 128;
    {
        int tid = tid_in, lane = lane_in;
        asm volatile("" : "+v"(tid), "+v"(lane));
        const int fr = lane & 15, fq = lane >> 4;
        const bool is_s = unit >= 256;
        const int bb = is_s ? 8 + (unit - 256) : (unit >> 5), c = is_s ? 0 : (unit & 31), sb = unit - 256;
        const int row0 = is_s ? MP + sb * 64 : bb * SEQ + c * 64;
        const bool first = is_s || c == 0;
        const size_t qrow = (size_t)row0 + qs * 16 + fr;
        unsigned zr = 0u; asm volatile("" : "+v"(zr));
        const v4u zero4 = (v4u){zr, zr, zr, zr};
        unsigned mskbits = 0u;
        v4u kst[6], vst[6];
        if constexpr (DO_SWA) {
            const bf16* ksrc[3]; const bf16* vsrc[3]; int kstr[3], vstr[3];
#pragma unroll
            for (int s = 0; s < 3; ++s) {
                if (is_s && s < 2) { ksrc[s] = CWK + ((size_t)(l * NBS + sb) * 128 + s * 64) * 128; kstr[s] = 128; vsrc[s] = CWVT + (size_t)(l * NBS + sb) * 16384 + s * 64; vstr[s] = 128; }
                else {
                    int cc = is_s ? 0 : c - 2 + s; if (cc < 0) { mskbits |= 1u << s; cc = 0; }
                    const int tok0 = is_s ? row0 : bb * SEQ + cc * 64;
                    ksrc[s] = UB + (size_t)tok0 * UBW + 512; kstr[s] = UBW; vsrc[s] = VTG + tok0; vstr[s] = MT;
                }
            }
#pragma unroll
            for (int i = 0; i < 6; ++i) {
                const int s = i >> 1, rem = tid + 512 * (i & 1);
                const bool mk = (mskbits >> s) & 1u;
                kst[i] = zero4; vst[i] = zero4;
                if (!mk) { kst[i] = __builtin_nontemporal_load((const v4u*)(ksrc[s] + (size_t)(rem >> 4) * kstr[s] + (rem & 15) * 8));
                           vst[i] = __builtin_nontemporal_load((const v4u*)(vsrc[s] + (size_t)(rem >> 3) * vstr[s] + (rem & 7) * 8)); }
            }
        }
        bf16x8 qsw[4][2], qmm[2][2];
        if constexpr (DO_SWA)
#pragma unroll
        for (int hh = 0; hh < 4; ++hh) { const bf16* qp = UB + qrow * UBW + (g * 4 + hh) * 64 + fq * 8; qsw[hh][0] = __builtin_nontemporal_load((const bf16x8*)qp); qsw[hh][1] = __builtin_nontemporal_load((const bf16x8*)(qp + 32)); }
        if constexpr (DO_MEM)
#pragma unroll
        for (int hp = 0; hp < 2; ++hp) { const bf16* qp = UB + qrow * UBW + 1152 + (hp * 2 + g) * 64 + fq * 8; qmm[hp][0] = __builtin_nontemporal_load((const bf16x8*)qp); qmm[hp][1] = __builtin_nontemporal_load((const bf16x8*)(qp + 32)); }
        const int cgp = tid & 31, tg = tid >> 5, ch = cgp * 8, t0 = tg * 4;
        v4u cu[6], ccb[4]; f32x4 cwv[6];
        if constexpr (DO_SWA) {
            const float* cw = a.in[13] + l * 768 + ch;
#pragma unroll
            for (int k = 0; k < 3; ++k) { cwv[2 * k] = *(const f32x4*)(cw + k * 256); cwv[2 * k + 1] = *(const f32x4*)(cw + k * 256 + 4); }
            const bf16* ub = UB + (size_t)(row0 + t0) * UBW;
#pragma unroll
            for (int r = 0; r < 6; ++r) {
                if (r >= 2 || tg > 0 || !first) cu[r] = __builtin_nontemporal_load((const v4u*)(ub + (ptrdiff_t)(r - 2) * UBW + 896 + ch));
                else if (is_s) { const float* sp = a.in[5] + (size_t)(l * NBS + sb) * 512 + r * 256 + ch; const f32x4 s0 = *(const f32x4*)sp, s1 = *(const f32x4*)(sp + 4);
                                 cu[r] = (v4u){pk2(s0[0], s0[1]), pk2(s0[2], s0[3]), pk2(s1[0], s1[1]), pk2(s1[2], s1[3])}; }
                else cu[r] = zero4;
            }
#pragma unroll
            for (int i = 0; i < 4; ++i) ccb[i] = __builtin_nontemporal_load((const v4u*)(ub + (size_t)i * UBW + 640 + ch));
        }
        __builtin_amdgcn_sched_barrier(0);
        if constexpr (DO_SWA) {
            float w0[8], w1[8], w2[8];
#pragma unroll
            for (int j = 0; j < 4; ++j) { w0[j] = cwv[0][j]; w0[4 + j] = cwv[1][j]; w1[j] = cwv[2][j]; w1[4 + j] = cwv[3][j]; w2[j] = cwv[4][j]; w2[4 + j] = cwv[5][j]; }
#pragma unroll
            for (int i = 0; i < 4; ++i) {
                float ua[8], ub_[8], uc[8], cbv[8], cy[8];
                unpack8(cu[i], ua); unpack8(cu[i + 1], ub_); unpack8(cu[i + 2], uc); unpack8(ccb[i], cbv);
                float ss = 0.f;
#pragma unroll
                for (int j = 0; j < 8; ++j) { const float y = ua[j] * w0[j] + ub_[j] * w1[j] + uc[j] * w2[j]; cy[j] = cbv[j] * y; ss += cy[j] * cy[j]; }
                ss += __shfl_xor(ss, 1); ss += __shfl_xor(ss, 2); ss += __shfl_xor(ss, 4); ss += __shfl_xor(ss, 8); ss += __shfl_xor(ss, 16);
                const float rs = 1.0f / sqrtf(ss * (1.0f / 256.0f) + EPS);
                v4u o; o.x = pk2(cy[0] * rs, cy[1] * rs); o.y = pk2(cy[2] * rs, cy[3] * rs); o.z = pk2(cy[4] * rs, cy[5] * rs); o.w = pk2(cy[6] * rs, cy[7] * rs);
                *(v4u*)(MIX + (size_t)(row0 + t0 + i) * D + 512 + ch) = o;
            }
        }
        if constexpr (DO_SWA)
#pragma unroll
        for (int i = 0; i < 6; ++i) {
            const int s = i >> 1, rem = tid + 512 * (i & 1);
            { const int key = rem >> 4, c16 = rem & 15; *(LAS v4u*)(lds + A_KS + ((c16 >> 3) * 192 + s * 64 + key) * 144 + (c16 & 7) * 16) = kst[i]; }
            { const int col = rem >> 3, kc = rem & 7; *(LAS v4u*)(lds + A_VT1 + col * 400 + (s * 64 + kc * 8) * 2) = vst[i]; }
        }
        const bf16* MKb = (const bf16*)(ws + WS_MK) + (size_t)(l * 40 + bb) * 65536;
        const bf16* MVTb = (const bf16*)(ws + WS_MVT) + (size_t)(l * 40 + bb) * 65536;
        v4u mkst[8], mvst[8];
        __builtin_amdgcn_sched_barrier(0);
        __syncthreads();
        v2u osv[4][4];
        if constexpr (DO_SWA) {
            float ssq = 0.f;
#pragma unroll
            for (int hh = 0; hh < 4; ++hh) {
                const int h = g * 4 + hh;
                const float sk = a.in[12][l * 8 + h] * LOG2E;
                f32x4 o[4];
                attn_core<12, 400, true>(lds + A_KS + g * 192 * 144 + fq * 16, lds + A_VT1 + (g * 64 + fr) * 400 + fq * 16, qsw[hh][0], qsw[hh][1], sk, mskbits, fr, o);
#pragma unroll
                for (int dt = 0; dt < 4; ++dt) { ssq += pg8::sq4(o[dt]); osv[hh][dt] = (v2u){pk2(o[dt][0], o[dt][1]), pk2(o[dt][2], o[dt][3])}; }
            }
            ssq = pg8::quad_sum(ssq);
            if (fq == 0) red_a[g * 64 + qs * 16 + fr] = ssq;
        }
        if constexpr (DO_MEM) {
#pragma unroll
            for (int i = 0; i < 8; ++i) {
                const int chn = tid + 512 * i;
                mkst[i] = *(const v4u*)(MKb + (size_t)(chn >> 4) * 256 + (chn & 15) * 8);
                mvst[i] = *(const v4u*)(MVTb + (size_t)(chn >> 5) * 256 + (chn & 31) * 8);
            }
        }
        __syncthreads();
        if constexpr (DO_MEM)
#pragma unroll
        for (int i = 0; i < 8; ++i) {
            const int chn = tid + 512 * i;
            { const int key = chn >> 4, c16 = chn & 15; *(LAS v4u*)(lds + A_KS + ((c16 >> 3) * 256 + key) * 144 + (c16 & 7) * 16) = mkst[i]; }
            { const int col = chn >> 5, kc = chn & 31; *(LAS v4u*)(lds + A_VT2 + col * 528 + kc * 16) = mvst[i]; }
        }
        if constexpr (DO_MEM)
#pragma unroll
        for (int i = 0; i < 8; ++i) {
            const int chn = tid + 512 * i;
            mkst[i] = *(const v4u*)(MKb + (size_t)(chn >> 4) * 256 + 128 + (chn & 15) * 8);
            mvst[i] = *(const v4u*)(MVTb + (size_t)(128 + (chn >> 5)) * 256 + (chn & 31) * 8);
        }
        __builtin_amdgcn_sched_barrier(0);
        if constexpr (DO_SWA) {
            const float tot = red_a[qs * 16 + fr] + red_a[64 + qs * 16 + fr];
            const float rs = 1.0f / sqrtf(tot * (1.0f / 512.0f) + EPS);
#pragma unroll
            for (int hh = 0; hh < 4; ++hh)
#pragma unroll
                for (int dt = 0; dt < 4; ++dt) {
                    const v2u p = osv[hh][dt];
                    v2u w; w.x = pk2(__uint_as_float(p.x << 16) * rs, __uint_as_float(p.x & 0xffff0000u) * rs); w.y = pk2(__uint_as_float(p.y << 16) * rs, __uint_as_float(p.y & 0xffff0000u) * rs);
                    *(v2u*)(MIX + qrow * D + (g * 4 + hh) * 64 + dt * 16 + 4 * fq) = w;
                }
        }
        __syncthreads();
        f32x4 omem[2][4];
        if constexpr (DO_MEM) attn_core<16, 528, false>(lds + A_KS + g * 256 * 144 + fq * 16, lds + A_VT2 + (g * 64 + fr) * 528 + fq * 16, qmm[0][0], qmm[0][1], 0.f, 0u, fr, omem[0]);
        __syncthreads();
        if constexpr (DO_MEM)
#pragma unroll
        for (int i = 0; i < 8; ++i) {
            const int chn = tid + 512 * i;
            { const int key = chn >> 4, c16 = chn & 15; *(LAS v4u*)(lds + A_KS + ((c16 >> 3) * 256 + key) * 144 + (c16 & 7) * 16) = mkst[i]; }
            { const int col = chn >> 5, kc = chn & 31; *(LAS v4u*)(lds + A_VT2 + col * 528 + kc * 16) = mvst[i]; }
        }
        __syncthreads();
        if constexpr (DO_MEM) {
            attn_core<16, 528, false>(lds + A_KS + g * 256 * 144 + fq * 16, lds + A_VT2 + (g * 64 + fr) * 528 + fq * 16, qmm[1][0], qmm[1][1], 0.f, 0u, fr, omem[1]);
            float ssq = 0.f;
#pragma unroll
            for (int hp = 0; hp < 2; ++hp)
#pragma unroll
                for (int dt = 0; dt < 4; ++dt) ssq += pg8::sq4(omem[hp][dt]);
            ssq = pg8::quad_sum(ssq);
            if (fq == 0) red_m[g * 64 + qs * 16 + fr] = ssq;
            __syncthreads();
            const float tot = red_m[qs * 16 + fr] + red_m[64 + qs * 16 + fr];
            const float rs = 1.0f / sqrtf(tot * (1.0f / 256.0f) + EPS);
#pragma unroll
            for (int hp = 0; hp < 2; ++hp)
#pragma unroll
                for (int dt = 0; dt < 4; ++dt) {
                    const f32x4 o = omem[hp][dt] * rs;
                    v2u w; w.x = pk2(o[0], o[1]); w.y = pk2(o[2], o[3]);
                    *(v2u*)(MIX + qrow * D + 768 + (hp * 2 + g) * 64 + dt * 16 + 4 * fq) = w;
                }
            __syncthreads();
        }
    }
}
__device__ __forceinline__ void attn_phase(const Args& a, unsigned char* ws, LAS unsigned char* lds, int l, int tid_in, int lane_in, int wave) {
    for (int unit0 = blockIdx.x; unit0 < NUNITS + 32; unit0 += gridDim.x) {
        if (unit0 < 256) attn_unit<true, true>(a, ws, lds, l, tid_in, lane_in, wave, unit0);
        else if (unit0 < 288) attn_unit<true, false>(a, ws, lds, l, tid_in, lane_in, wave, unit0);
        else attn_unit<false, true>(a, ws, lds, l, tid_in, lane_in, wave, unit0 - 32);
    }
}

__device__ __forceinline__ void small_gemm_res(LAS unsigned char* lds, const bf16* A, const bf16* Bt, int K, const float* base_s, float* out, bf16* AB, float* PS, int sm, int sn, int tid_in, bool last = false) {
    int tid = tid_in; asm volatile("" : "+v"(tid));
    const int lane = tid & 63, wave = __builtin_amdgcn_readfirstlane(tid >> 6), wr = wave >> 2, wc = wave & 3, fr = lane & 15, fq = lane >> 4;
    constexpr int A_OFF = 0, B_OFF = 8192, STAGE = 24576, NS = 4;
    const int row0 = MP + sm * 64, col0 = sn * 128;
    int R0, C0, R1, C1; pg8::stage_rc(tid * 16, R0, C0); pg8::stage_rc(tid * 16 + 8192, R1, C1);
    const char* ga = (const char*)(A + (size_t)(row0 + R0) * K + C0);
    const char* gb0 = (const char*)(Bt + (size_t)(col0 + R0) * K + C0);
    const char* gb1 = (const char*)(Bt + (size_t)(col0 + R1) * K + C1);
    const unsigned ldsw = (unsigned)wave * 1024u;
#define SG_ISSUE(t_) do { const int so_ = ((t_) & (NS - 1)) * STAGE; const size_t ko_ = (size_t)(t_) * 128; \
        __builtin_amdgcn_global_load_lds((const unsigned*)(ga + ko_), (LAS unsigned*)(lds + so_ + A_OFF + ldsw), 16, 0, 0); \
        __builtin_amdgcn_global_load_lds((const unsigned*)(gb0 + ko_), (LAS unsigned*)(lds + so_ + B_OFF + ldsw), 16, 0, 0); \
        __builtin_amdgcn_global_load_lds((const unsigned*)(gb1 + ko_), (LAS unsigned*)(lds + so_ + B_OFF + 8192 + ldsw), 16, 0, 0); } while (0)
    const int nt = K / 64;
    SG_ISSUE(0); SG_ISSUE(1); SG_ISSUE(2);
    f32x4 acc[2][2];
#pragma unroll
    for (int m_ = 0; m_ < 2; ++m_)
#pragma unroll
        for (int n = 0; n < 2; ++n) acc[m_][n] = (f32x4){0.f, 0.f, 0.f, 0.f};
    const int aoff = A_OFF + pg8::lds_byte(wr * 32 + fr, fq * 8), boff = B_OFF + pg8::lds_byte(wc * 32 + fr, fq * 8);
    for (int t = 0; t < nt; ++t) {
        if (t + 2 < nt) asm volatile("s_waitcnt vmcnt(6)" ::: "memory");
        else if (t + 1 < nt) asm volatile("s_waitcnt vmcnt(3)" ::: "memory");
        else asm volatile("s_waitcnt vmcnt(0)" ::: "memory");
        asm volatile("s_waitcnt lgkmcnt(0)" ::: "memory");
        __builtin_amdgcn_s_barrier();
        asm volatile("" ::: "memory");
        if (t + 3 < nt) SG_ISSUE(t + 3);
        const int cur = (t & (NS - 1)) * STAGE;
#pragma unroll
        for (int kk = 0; kk < 2; ++kk) {
            bf16x8 af[2], bfr[2];
#pragma unroll
            for (int i = 0; i < 2; ++i) { af[i] = *(LAS const bf16x8*)(lds + cur + aoff + i * 2048 + kk * 1024); bfr[i] = *(LAS const bf16x8*)(lds + cur + boff + i * 2048 + kk * 1024); }
#pragma unroll
            for (int m_ = 0; m_ < 2; ++m_)
#pragma unroll
                for (int n = 0; n < 2; ++n) acc[m_][n] = mfma16(bfr[n], af[m_], acc[m_][n]);
        }
    }
#undef SG_ISSUE
    asm volatile("s_waitcnt lgkmcnt(0)" ::: "memory");
    __builtin_amdgcn_s_barrier();
    asm volatile("" ::: "memory");
    constexpr int STAGE_END = NS * STAGE;
    LAS float* red = (LAS float*)(lds + STAGE_END);
    f32x4 bv[2][2];
#pragma unroll
    for (int m_ = 0; m_ < 2; ++m_)
#pragma unroll
        for (int n = 0; n < 2; ++n) bv[m_][n] = *(const f32x4*)(base_s + (size_t)(row0 + wr * 32 + m_ * 16 + fr - MP) * D + col0 + wc * 32 + n * 16 + 4 * fq);
#pragma unroll
    for (int m_ = 0; m_ < 2; ++m_) {
        const int rl = wr * 32 + m_ * 16 + fr, row = row0 + rl;
        float ss = 0.f;
#pragma unroll
        for (int n = 0; n < 2; ++n) {
            const int c = col0 + wc * 32 + n * 16 + 4 * fq;
            const f32x4 y = bv[m_][n] + acc[m_][n];
            if (last) __builtin_nontemporal_store(y, (f32x4*)(out + (size_t)row * D + c));
            else { *(f32x4*)(out + (size_t)row * D + c) = y; *(v2u*)(AB + (size_t)row * D + c) = (v2u){pk2(y[0], y[1]), pk2(y[2], y[3])}; }
            ss += pg8::sq4(y);
        }
        ss = pg8::quad_sum(ss);
        if (fq == 0) red[rl * 4 + wc] = ss;
    }
    __syncthreads();
    if (tid < 128 && !last) { const int r = tid >> 1, sl = tid & 1; PS[(size_t)(row0 + r) * 16 + sn * 2 + sl] = red[r * 4 + sl * 2] + red[r * 4 + sl * 2 + 1]; }
    __syncthreads();
}

#ifndef PROBE_MASK
#define PROBE_MASK 0
#endif
#ifndef PHMASK
#define PHMASK 127
#endif
#ifndef USE_CG_SYNC
#define USE_CG_SYNC 1
#endif
__global__ void __launch_bounds__(NWAVES * 64, 2) hymba_fwd(Args args) {
    extern __shared__ __attribute__((aligned(16))) unsigned char lds_raw[];
    LAS unsigned char* lds = (LAS unsigned char*)lds_raw;
    const int tid = threadIdx.x, lane = tid & 63, wave = __builtin_amdgcn_readfirstlane(tid >> 6);
    const int lo = args.ph_lo, hi = args.ph_hi;
    volatile LAS unsigned* MISC = (volatile LAS unsigned*)(lds + MISC_OFF);
    if (tid < 32) MISC[tid] = 0u;
    __syncthreads();
    XcdBarrier bar = xcd_barrier_post((unsigned*)(args.ws + WS_CTL) + CW_BAR, MISC + 8);
#if USE_CG_SYNC == 1
#define GRID_BAR(ph) cg::this_grid().sync()
#elif USE_CG_SYNC == 2
#define GRID_BAR(ph) do { if ((ph) == 0) cg::this_grid().sync(); else xcd_barrier(bar); } while (0)
#elif USE_CG_SYNC == 3
    if (lo < 0) cg::this_grid().sync();
#define GRID_BAR(ph) xcd_barrier(bar)
#else
#define GRID_BAR(ph) xcd_barrier(bar)
#endif
    const int G = gridDim.x;
    for (int ph = lo; ph < hi; ++ph) {
        size_t zoff = 0; asm volatile("" : "+s"(zoff));
        unsigned char* ws = args.ws + zoff;
        if (ph == 0) {
            if (PHMASK & 1) p0_prologue(args, ws, lds, tid, lane, wave);
#if PROBE_MASK & 1
            __syncthreads(); p0_prologue(args, ws, lds, tid, lane, wave);
#endif
        } else {
            const int l = (ph - 1) / 5, sub = (ph - 1) % 5;
            if (sub == 0) {
                if ((PHMASK & 2) && l == 0) {
                    pg8::Gemm gm{(const pg8::bf16_t*)(ws + WS_MEMB), (const pg8::bf16_t*)(ws + WS_WMEM), NBP * NMEM, DEPTH * 512, D};
                    pg8::StaticOrder S; S.init(NBP * NMEM, DEPTH * 512, G, (int)blockIdx.x);
                    pg8::EpiMem E{ws, args.out};
                    pg8::gemm_phase<pg8::EpiMem, pg8::StaticOrder, true, true>(lds, gm, S, E);
                }
                pg8::Gemm gm{(const pg8::bf16_t*)(ws + WS_AB), (const pg8::bf16_t*)(ws + WS_WIN) + (size_t)l * INW * D, MT, INW, D};
                pg8::StaticOrder S; S.init(MT, INW, G, (int)blockIdx.x);
                pg8::EpiIn E{ws, args.out, lds, l, 0};
                if (PHMASK & 4) pg8::gemm_phase<pg8::EpiIn, pg8::StaticOrder, true, true>(lds, gm, S, E);
                if (l == 0 && blockIdx.x >= 64) {
                    int ln = lane; asm volatile("" : "+v"(ln));
                    convert_layer_weights(args, ws, (LAS float*)(lds + wave * 16384), 0, ((int)blockIdx.x - 64) * NWAVES + wave, (G - 64) * NWAVES, ln, 14);
                }
            } else if (sub == 1) {
                if (PHMASK & 8) attn_phase(args, ws, lds, l, tid, lane, wave);
                if (l + 1 < DEPTH && blockIdx.x >= 64) {
                    int ln = lane; asm volatile("" : "+v"(ln));
                    convert_layer_weights(args, ws, (LAS float*)(lds + wave * 16384), l + 1, ((int)blockIdx.x - 64) * NWAVES + wave, (G - 64) * NWAVES, ln, 3);
                    if (l == 0) { int tn = tid; asm volatile("" : "+v"(tn)); copy_window_outputs(args, ((int)blockIdx.x - 64) * (NWAVES * 64) + tn, (G - 64) * NWAVES * 64); }
                }
#if PROBE_MASK & 2
                __syncthreads(); attn_phase(args, ws, lds, l, tid, lane, wave);
#endif
            } else if (sub == 2) {
                pg8::Gemm gm{(const pg8::bf16_t*)(ws + WS_MIX), (const pg8::bf16_t*)(ws + WS_WOUT) + (size_t)l * D * D, MT, D, D};
                pg8::StaticOrder S; S.init(MP, D, G, (int)blockIdx.x);
                pg8::EpiRes E{l == 0 ? args.in[0] : args.out + O_YP, l == 0 ? args.in[1] : args.out + O_YS, args.out, ws, 0, 0};
                if (PHMASK & 16) pg8::gemm_phase<pg8::EpiRes, pg8::StaticOrder, true, true>(lds, gm, S, E);
                for (int st = (int)blockIdx.x; st < 256; st += G)
                    small_gemm_res(lds, (const bf16*)(ws + WS_MIX), (const bf16*)(ws + WS_WOUT) + (size_t)l * D * D, D, l == 0 ? args.in[1] : args.out + O_YS, args.out, (bf16*)(ws + WS_AB), (float*)(ws + WS_PS), (st & 7) * 4 + ((st >> 3) & 3), st >> 5, tid);
            } else if (sub == 3) {
                pg8::Gemm gm{(const pg8::bf16_t*)(ws + WS_AB), (const pg8::bf16_t*)(ws + WS_WGU) + (size_t)l * 2 * DFF * D, MT, 2 * DFF, D};
                pg8::StaticOrder S; S.init(MT, 2 * DFF, G, (int)blockIdx.x);
                pg8::EpiGU E{ws, lds};
                if (PHMASK & 32) pg8::gemm_phase<pg8::EpiGU, pg8::StaticOrder, true, true>(lds, gm, S, E);
                if (l + 1 < DEPTH && blockIdx.x >= 48) {
                    int ln = lane, tn = tid; asm volatile("" : "+v"(ln), "+v"(tn));
                    const int wk = ((int)blockIdx.x - 48) * NWAVES + wave, nwk = (G - 48) * NWAVES;
                    convert_layer_weights(args, ws, (LAS float*)(lds + wave * 16384), l + 1, wk, nwk, ln, 12);
                    convert_layer_caches(args, ws, (LAS float*)(lds + wave * 16384), l + 1, wk, nwk, ((int)blockIdx.x - 48) * (NWAVES * 64) + tn, (G - 48) * NWAVES * 64, ln);
                }
#if PROBE_MASK & 4
                __syncthreads(); pg8::gemm_phase<pg8::EpiGU, pg8::StaticOrder, true, true>(lds, gm, S, E);
#endif
            } else {
                pg8::Gemm gm{(const pg8::bf16_t*)(ws + WS_ACT), (const pg8::bf16_t*)(ws + WS_WDN) + (size_t)l * D * DFF, MT, D, DFF};
                pg8::StaticOrder S; S.init(MP, D, G, (int)blockIdx.x);
                pg8::EpiRes E{args.out + O_YP, args.out + O_YS, args.out, ws, (l == DEPTH - 1) ? 1 : 0, 0};
                if (PHMASK & 64) pg8::gemm_phase<pg8::EpiRes, pg8::StaticOrder, true, true>(lds, gm, S, E);
                for (int st = (int)blockIdx.x; st < 256; st += G)
                    small_gemm_res(lds, (const bf16*)(ws + WS_ACT), (const bf16*)(ws + WS_WDN) + (size_t)l * D * DFF, DFF, args.out + O_YS, args.out, (bf16*)(ws + WS_AB), (float*)(ws + WS_PS), (st & 7) * 4 + ((st >> 3) & 3), st >> 5, tid, l == DEPTH - 1);
            }
        }
        if (ph + 1 < hi) GRID_BAR(ph);
    }
}

#ifndef N_LAUNCH_MODE
#define N_LAUNCH_MODE 0
#endif
extern "C" void kernel_launch(void* const* d_in, const int* in_sizes, int n_in, void* d_out, int out_size, void* d_ws, size_t ws_size, hipStream_t stream) {
    static int grid = 0;
    if (grid == 0) {
        if (n_in != 23 || (size_t)out_size != O_END || ws_size < WS_END) { fprintf(stderr, "kernel_launch: unexpected shapes n_in %d out %d ws %zu\n", n_in, out_size, ws_size); grid = -1; return; }
        int dev = 0, cus = 0, per_cu = 0;
        if (hipGetDevice(&dev) != hipSuccess || hipDeviceGetAttribute(&cus, hipDeviceAttributeMultiprocessorCount, dev) != hipSuccess) { grid = -1; return; }
        if (hipFuncSetAttribute((const void*)hymba_fwd, hipFuncAttributeMaxDynamicSharedMemorySize, LDS_BYTES) != hipSuccess) { fprintf(stderr, "kernel_launch: hipFuncSetAttribute failed\n"); grid = -1; return; }
        if (hipOccupancyMaxActiveBlocksPerMultiprocessor(&per_cu, (const void*)hymba_fwd, NWAVES * 64, LDS_BYTES) != hipSuccess || per_cu < 1) { fprintf(stderr, "kernel_launch: occupancy query says %d\n", per_cu); per_cu = 1; }
        (void)hipGetLastError();
        grid = cus;
    }
    if (grid < 0) return;
    Args a{};
    for (int i = 0; i < 23; ++i) a.in[i] = (const float*)d_in[i];
    a.out = (float*)d_out; a.ws = (unsigned char*)d_ws;
#if N_LAUNCH_MODE == 0
    for (int ph = 0; ph < NPHASE; ++ph) {
        a.ph_lo = ph; a.ph_hi = ph + 1;
        hipLaunchKernelGGL(hymba_fwd, dim3(grid), dim3(NWAVES * 64), LDS_BYTES, stream, a);
    }
#else
    (void)hipMemsetAsync((char*)d_ws + WS_CTL, 0, CTL_ZERO_BYTES, stream);
    a.ph_lo = 0; a.ph_hi = NPHASE;
    void* kargs[] = {&a};
    hipError_t e = hipLaunchCooperativeKernel((const void*)hymba_fwd, dim3(grid), dim3(NWAVES * 64), kargs, LDS_BYTES, stream);
    if (e != hipSuccess) fprintf(stderr, "kernel_launch: cooperative launch failed: %s (grid %d)\n", hipGetErrorString(e), grid);
#endif
}
```

```cpp
#include <hip/hip_runtime.h>
#include <hip/hip_cooperative_groups.h>
#include <cstdio>
#include <cstdint>
namespace cg = cooperative_groups;
#define GAS __attribute__((address_space(1)))
#define LAS __attribute__((address_space(3)))
constexpr int MT_ = 18432;
constexpr size_t MiB = 1u << 20;
constexpr size_t WS_CTL = 0, CTL_ZERO_BYTES = 1 * MiB;
constexpr size_t WS_WIN = 1 * MiB, WS_WOUT = WS_WIN + 14 * MiB, WS_WGU = WS_WOUT + 8 * MiB, WS_WDN = WS_WGU + 44 * MiB, WS_WMEM = WS_WDN + 22 * MiB;
constexpr size_t WS_AB = WS_WMEM + 4 * MiB, WS_MEMB = WS_AB + 36 * MiB, WS_MRS = WS_MEMB + 4 * MiB, WS_PS = WS_MRS + 1 * MiB;
constexpr size_t WS_MK = WS_PS + 2 * MiB, WS_MVT = WS_MK + 20 * MiB, WS_CWK = WS_MVT + 20 * MiB, WS_CWVT = WS_CWK + 4 * MiB, WS_VTG = WS_CWVT + 4 * MiB;
constexpr size_t WS_R1 = WS_VTG + 5 * MiB, WS_UB = WS_R1, WS_MIX = WS_R1 + 50 * MiB, WS_ACT = WS_R1, WS_END = WS_R1 + 100 * MiB;
static_assert((size_t)18432 * 1408 * 2 <= 50 * MiB && (size_t)18432 * 1024 * 2 <= 36 * MiB && (size_t)18432 * 2816 * 2 <= 100 * MiB && (size_t)128 * 18432 * 2 <= 5 * MiB, "ws map");
constexpr int CW_BAR = 4096;

constexpr size_t O_YP = 0, O_YS = 16777216, O_WKP = 18874368, O_WVP = 19398656, O_CVP = 19922944, O_MKP = 19939328, O_MVP = 22036480,
                 O_WKS = 24133632, O_WVS = 26230784, O_CVS = 28327936, O_END = 28393472;

constexpr size_t WS_GT = WS_MRS + 65536;
#define N_LAUNCH_MODE 1
#define USE_CG_SYNC 3
namespace pg8 {
#define PG8_LAS __attribute__((address_space(3)))
typedef unsigned short bf16_t;
typedef short bf16x8 __attribute__((ext_vector_type(8)));
typedef float f32x4 __attribute__((ext_vector_type(4)));
typedef unsigned u32x4 __attribute__((ext_vector_type(4)));
constexpr int BM = 256, BK = 64, HALF = 128, HTB = HALF * BK * 2  , STAGE_BYTES = 8 * HTB, NXCD = 8, WGM = 8;

__host__ __device__ __forceinline__ int lds_byte(int r, int c) { const int st = (r >> 4) * 2 + (c >> 5), rr = r & 15, cc = c & 31, ob = rr * 64 + cc * 2; return st * 1024 + (ob ^ (((ob >> 9) & 1) << 5)); }
__host__ __device__ __forceinline__ void stage_rc(int b, int& R, int& C) { const int st = b / 1024, sb = b % 1024, swz = sb ^ (((sb >> 9) & 1) << 5); R = (st >> 1) * 16 + swz / 64; C = (st & 1) * 32 + (swz % 64) / 2; }
__host__ __device__ __forceinline__ int perm32(int rho) { const int n = rho >> 4, i = rho & 15; return 8 * (i >> 2) + 4 * n + (i & 3); }

struct Unit { int pm, pn; };
struct Gemm { const bf16_t* A; const bf16_t* Bt; int M, N, K; };

struct StaticOrder {
    int nM, nN, nwg, G, c;
    __host__ __device__ void init(int M, int N, int G_, int c_) { nM = M / BM; nN = N / BM; nwg = nM * nN; G = G_; c = c_; }
    __host__ __device__ bool next(int i, Unit& u) const {
        const long L = (long)i * G + c; if (L >= nwg) return false;
        int wgid = (int)L; { const int q = nwg / NXCD, r = nwg % NXCD, xcd = wgid % NXCD, off = wgid / NXCD; wgid = (xcd < r ? xcd * (q + 1) : r * (q + 1) + (xcd - r) * q) + off; }
        const int nig = WGM * nN, gid = wgid / nig, fm = gid * WGM, gsz = (nM - fm) < WGM ? (nM - fm) : WGM;
        u.pm = fm + ((wgid % nig) % gsz); u.pn = (wgid % nig) / gsz; return true;
    }
    __device__ __forceinline__ void a_ready(const Unit&) const {}
    __device__ __forceinline__ void done(const Unit&) const {}
};

__device__ __forceinline__ unsigned cvt_pk_bf16(float lo, float hi) { unsigned r; asm volatile("v_cvt_pk_bf16_f32 %0, %1, %2" : "=v"(r) : "v"(lo), "v"(hi)); return r; }

typedef unsigned u32x2 __attribute__((ext_vector_type(2)));
constexpr int E_MT = 18432, E_MP = 16384, E_UBW = 1408;
constexpr float E_EPS = 1e-6f;
constexpr float E_C2 = 0.125f * 1.4426950408889634f;

__device__ __forceinline__ float quad_sum(float s) { s += __shfl_xor(s, 16); s += __shfl_xor(s, 32); return s; }
__device__ __forceinline__ float sum4(const f32x4 a) { return (a[0] + a[1]) + (a[2] + a[3]); }
__device__ __forceinline__ float sq4(const f32x4 a) { return (a[0] * a[0] + a[1] * a[1]) + (a[2] * a[2] + a[3] * a[3]); }
__device__ __forceinline__ float row_rstd(const float* ps_row) {
    const f32x4* p = (const f32x4*)ps_row; const f32x4 a = p[0], b = p[1], c = p[2], d = p[3];
    const float s = (sum4(a) + sum4(b)) + (sum4(c) + sum4(d));
    return 1.0f / sqrtf(s * (1.0f / 1024.0f) + E_EPS);
}
__device__ __forceinline__ u32x4 pack8(const f32x4 a, const f32x4 b) { u32x4 w; w.x = cvt_pk_bf16(a[0], a[1]); w.y = cvt_pk_bf16(a[2], a[3]); w.z = cvt_pk_bf16(b[0], b[1]); w.w = cvt_pk_bf16(b[2], b[3]); return w; }
__device__ __forceinline__ bf16_t f2bf1(float f) { return (bf16_t)(cvt_pk_bf16(f, 0.f) & 0xffffu); }


__device__ __forceinline__ PG8_LAS const float* stage_rstd(const float* PS, PG8_LAS unsigned char* lds, int pm) {
    int t = threadIdx.x; asm volatile("" : "+v"(t));
    PG8_LAS float* R = (PG8_LAS float*)(lds + 131072);
    if (t < 256) R[t] = row_rstd(PS + (size_t)(pm * BM + t) * 16);
    asm volatile("s_waitcnt lgkmcnt(0)" ::: "memory");
    __builtin_amdgcn_s_barrier();
    asm volatile("" ::: "memory");
    return R;
}
struct EpiIn {
    static constexpr bool PERM = true, AFTER_DRAIN = false;
    unsigned char* ws; float* out; PG8_LAS unsigned char* lds; int l, pad;
    __device__ __forceinline__ void operator()(const f32x4 (&acc)[2][2][4][2], const Unit& u, int wr, int wc, int fr, int fq) const {
        const int pn = u.pn;
        bf16_t* UB = (bf16_t*)(ws + WS_UB);
        PG8_LAS const float* R = stage_rstd((const float*)(ws + WS_PS), lds, u.pm);
        const bool is_s = (u.pm >= 64);
        if (pn <= 1 || pn == 6 || (pn == 2 && wc < 2)) {
            const float* g = (const float*)(ws + WS_GT) + l * 256 + ((pn <= 1) ? 0 : ((pn == 6) ? 128 : 64));
            const int colbase = (pn <= 1) ? (pn * 4 + wc) * 64 : ((pn == 6) ? 1152 + wc * 64 : 512 + wc * 64);
            const float sc = (pn == 2) ? 1.0f : E_C2;
            float* okp = out + O_WKP + (size_t)l * 131072; float* oks = out + O_WKS + (size_t)l * 524288;
            f32x4 gv[2][2];
#pragma unroll
            for (int bj = 0; bj < 2; ++bj) { gv[bj][0] = *(const f32x4*)(g + bj * 32 + 8 * fq); gv[bj][1] = *(const f32x4*)(g + bj * 32 + 8 * fq + 4); }
#pragma unroll
            for (int ai = 0; ai < 2; ++ai)
#pragma unroll
                for (int m = 0; m < 4; ++m) {
                    int row = u.pm * BM + ai * HALF + wr * 64 + m * 16 + fr;
                    asm volatile("" : "+v"(row));
                    const float rs = R[ai * HALF + wr * 64 + m * 16 + fr];
                    f32x4 v[2][2];
#pragma unroll
                    for (int bj = 0; bj < 2; ++bj)
#pragma unroll
                        for (int n = 0; n < 2; ++n) v[bj][n] = acc[ai][bj][m][n] * rs;
                    float ss = (sq4(v[0][0]) + sq4(v[0][1])) + (sq4(v[1][0]) + sq4(v[1][1]));
                    ss = quad_sum(ss);
                    const float hr = (1.0f / sqrtf(ss * (1.0f / 64.0f) + E_EPS)) * sc;
#pragma unroll
                    for (int bj = 0; bj < 2; ++bj) {
                        const int c0 = bj * 32 + 8 * fq;
                        const f32x4 o0 = v[bj][0] * hr * gv[bj][0], o1 = v[bj][1] * hr * gv[bj][1];
                        *(u32x4*)(UB + (size_t)row * E_UBW + colbase + c0) = pack8(o0, o1);
                        if (pn == 2) {
                            const int sb = (row - E_MP) >> 6, st = (row - E_MP) & 63, pb = row >> 11, pt = row & 2047;
                            if (is_s) { float* d = oks + ((size_t)(sb * 128 + 64 + st) * 128 + wc * 64 + c0); __builtin_nontemporal_store(o0, (f32x4*)d); __builtin_nontemporal_store(o1, (f32x4*)(d + 4)); }
                            else if (pt >= 1920) { float* d = okp + ((size_t)(pb * 128 + (pt - 1920)) * 128 + wc * 64 + c0); __builtin_nontemporal_store(o0, (f32x4*)d); __builtin_nontemporal_store(o1, (f32x4*)(d + 4)); }
                        }
                    }
                }
        } else if (pn == 2) {
            bf16_t* VTG = (bf16_t*)(ws + WS_VTG);
            float* ovp = out + O_WVP + (size_t)l * 131072; float* ovs = out + O_WVS + (size_t)l * 524288;
#pragma unroll
            for (int ai = 0; ai < 2; ++ai)
#pragma unroll
                for (int m = 0; m < 4; ++m) {
                    int row = u.pm * BM + ai * HALF + wr * 64 + m * 16 + fr;
                    asm volatile("" : "+v"(row));
                    const float rs = R[ai * HALF + wr * 64 + m * 16 + fr];
                    const int sb = (row - E_MP) >> 6, st = (row - E_MP) & 63, pb = row >> 11, pt = row & 2047;
#pragma unroll
                    for (int bj = 0; bj < 2; ++bj) {
                        const f32x4 v0 = acc[ai][bj][m][0] * rs, v1 = acc[ai][bj][m][1] * rs;
                        const int c0 = (wc - 2) * 64 + bj * 32 + 8 * fq;
                        bf16_t* vp = VTG + (size_t)c0 * E_MT + row;
#pragma unroll
                        for (int j = 0; j < 4; ++j) { vp[(size_t)j * E_MT] = f2bf1(v0[j]); vp[(size_t)(4 + j) * E_MT] = f2bf1(v1[j]); }
                        if (is_s) { float* d = ovs + ((size_t)(sb * 128 + 64 + st) * 128 + c0); __builtin_nontemporal_store(v0, (f32x4*)d); __builtin_nontemporal_store(v1, (f32x4*)(d + 4)); }
                        else if (pt >= 1920) { float* d = ovp + ((size_t)(pb * 128 + (pt - 1920)) * 128 + c0); __builtin_nontemporal_store(v0, (f32x4*)d); __builtin_nontemporal_store(v1, (f32x4*)(d + 4)); }
                    }
                }
        } else if (pn == 3) {
#pragma unroll
            for (int ai = 0; ai < 2; ++ai)
#pragma unroll
                for (int m = 0; m < 4; ++m) {
                    int row = u.pm * BM + ai * HALF + wr * 64 + m * 16 + fr;
                    asm volatile("" : "+v"(row));
                    const float rs = R[ai * HALF + wr * 64 + m * 16 + fr];
#pragma unroll
                    for (int bj = 0; bj < 2; ++bj)
                        *(u32x4*)(UB + (size_t)row * E_UBW + 640 + wc * 64 + bj * 32 + 8 * fq) = pack8(acc[ai][bj][m][0] * rs, acc[ai][bj][m][1] * rs);
                }
        } else {
            float* ocp = out + O_CVP + (size_t)l * 4096; float* ocs = out + O_CVS + (size_t)l * 16384;
#pragma unroll
            for (int ai = 0; ai < 2; ++ai)
#pragma unroll
                for (int m = 0; m < 4; ++m) {
                    int row = u.pm * BM + ai * HALF + wr * 64 + m * 16 + fr;
                    asm volatile("" : "+v"(row));
                    const float rs = R[ai * HALF + wr * 64 + m * 16 + fr];
                    const float rs2 = rs * rs;
                    const f32x4 p0 = acc[ai][0][m][0] * acc[ai][1][m][0] * rs2, p1 = acc[ai][0][m][1] * acc[ai][1][m][1] * rs2;
                    const int ch0 = (pn - 4) * 128 + wc * 32 + 8 * fq;
                    *(u32x4*)(UB + (size_t)row * E_UBW + 896 + ch0) = pack8(p0, p1);
                    const int sb = (row - E_MP) >> 6, st = (row - E_MP) & 63, pb = row >> 11, pt = row & 2047;
                    if (is_s) { if (st >= 62) { float* d = ocs + ((size_t)(sb * 2 + (st - 62)) * 256 + ch0); __builtin_nontemporal_store(p0, (f32x4*)d); __builtin_nontemporal_store(p1, (f32x4*)(d + 4)); } }
                    else if (pt >= 2046) { float* d = ocp + ((size_t)(pb * 2 + (pt - 2046)) * 256 + ch0); __builtin_nontemporal_store(p0, (f32x4*)d); __builtin_nontemporal_store(p1, (f32x4*)(d + 4)); }
                }
        }
    }
};

struct EpiMem {
    static constexpr bool PERM = true, AFTER_DRAIN = false;
    unsigned char* ws; float* out;
    __device__ __forceinline__ void operator()(const f32x4 (&acc)[2][2][4][2], const Unit& u, int wr, int wc, int fr, int fq) const {
        const int l = u.pn >> 1, kind = u.pn & 1, b = u.pm;
        const float* MRS = (const float*)(ws + WS_MRS);
        if (kind == 0) {
            bf16_t* MK = (bf16_t*)(ws + WS_MK); float* o_mk = out + O_MKP;
            const float* g = (const float*)(ws + WS_GT) + l * 256 + 192;
#pragma unroll
            for (int ai = 0; ai < 2; ++ai)
#pragma unroll
                for (int m = 0; m < 4; ++m) {
                    int mrow = ai * HALF + wr * 64 + m * 16 + fr;
                    asm volatile("" : "+v"(mrow));
                    const float rs = MRS[b * 256 + mrow];
                    f32x4 v[2][2];
#pragma unroll
                    for (int bj = 0; bj < 2; ++bj)
#pragma unroll
                        for (int n = 0; n < 2; ++n) v[bj][n] = acc[ai][bj][m][n] * rs;
                    float ss = (sq4(v[0][0]) + sq4(v[0][1])) + (sq4(v[1][0]) + sq4(v[1][1]));
                    ss = quad_sum(ss);
                    const float hr = 1.0f / sqrtf(ss * (1.0f / 64.0f) + E_EPS);
#pragma unroll
                    for (int bj = 0; bj < 2; ++bj) {
                        const int c0 = bj * 32 + 8 * fq;
                        const f32x4 g0 = *(const f32x4*)(g + c0), g1 = *(const f32x4*)(g + c0 + 4);
                        const f32x4 o0 = v[bj][0] * hr * g0, o1 = v[bj][1] * hr * g1;
                        *(u32x4*)(MK + ((size_t)(l * 40 + b) * 256 + mrow) * 256 + wc * 64 + c0) = pack8(o0, o1);
                        float* d = o_mk + ((size_t)(l * 8 + b) * 256 + mrow) * 256 + wc * 64 + c0; __builtin_nontemporal_store(o0, (f32x4*)d); __builtin_nontemporal_store(o1, (f32x4*)(d + 4));
                    }
                }
        } else {
            bf16_t* MVT = (bf16_t*)(ws + WS_MVT); float* o_mv = out + O_MVP;
#pragma unroll
            for (int ai = 0; ai < 2; ++ai)
#pragma unroll
                for (int m = 0; m < 4; ++m) {
                    int mrow = ai * HALF + wr * 64 + m * 16 + fr;
                    asm volatile("" : "+v"(mrow));
                    const float rs = MRS[b * 256 + mrow];
#pragma unroll
                    for (int bj = 0; bj < 2; ++bj) {
                        const f32x4 v0 = acc[ai][bj][m][0] * rs, v1 = acc[ai][bj][m][1] * rs;
                        const int c0 = wc * 64 + bj * 32 + 8 * fq;
                        bf16_t* vp = MVT + ((size_t)(l * 40 + b) * 256 + c0) * 256 + mrow;
#pragma unroll
                        for (int j = 0; j < 4; ++j) { vp[j * 256] = f2bf1(v0[j]); vp[(4 + j) * 256] = f2bf1(v1[j]); }
                        float* d = o_mv + ((size_t)(l * 8 + b) * 256 + mrow) * 256 + c0; __builtin_nontemporal_store(v0, (f32x4*)d); __builtin_nontemporal_store(v1, (f32x4*)(d + 4));
                    }
                }
        }
    }
};

struct EpiRes {
    static constexpr bool PERM = true, AFTER_DRAIN = false;
    const float* base_p; const float* base_s; float* out; unsigned char* ws;
    __device__ __forceinline__ void operator()(const f32x4 (&acc)[2][2][4][2], const Unit& u, int wr, int wc, int fr, int fq) const {
        bf16_t* AB = (bf16_t*)(ws + WS_AB); float* PS = (float*)(ws + WS_PS);
        const int col0 = u.pn * BM + wc * 32 + 8 * fq;
#pragma unroll
        for (int ai = 0; ai < 2; ++ai) {
            f32x4 bv[4][2][2];
#pragma unroll
            for (int m = 0; m < 4; ++m) {
                const int row = u.pm * BM + ai * HALF + wr * 64 + m * 16 + fr;
                const float* bp = (u.pm < 64) ? base_p + (size_t)row * 1024 : base_s + (size_t)(row - E_MP) * 1024;
#pragma unroll
                for (int bj = 0; bj < 2; ++bj) { bv[m][bj][0] = *(const f32x4*)(bp + col0 + bj * HALF); bv[m][bj][1] = *(const f32x4*)(bp + col0 + bj * HALF + 4); }
            }
#pragma unroll
            for (int m = 0; m < 4; ++m) {
                const int row = u.pm * BM + ai * HALF + wr * 64 + m * 16 + fr;
                float ss = 0.f;
#pragma unroll
                for (int bj = 0; bj < 2; ++bj) {
                    const int c = col0 + bj * HALF;
                    const f32x4 y0 = bv[m][bj][0] + acc[ai][bj][m][0], y1 = bv[m][bj][1] + acc[ai][bj][m][1];
                    float* d = out + (size_t)row * 1024 + c; *(f32x4*)d = y0; *(f32x4*)(d + 4) = y1;
                    *(u32x4*)(AB + (size_t)row * 1024 + c) = pack8(y0, y1);
                    ss += sq4(y0) + sq4(y1);
                }
                ss = quad_sum(ss);
                if (fq == 0) PS[(size_t)row * 16 + u.pn * 4 + wc] = ss;
            }
        }
    }
};

struct EpiGU {
    static constexpr bool PERM = true, AFTER_DRAIN = false;
    unsigned char* ws; PG8_LAS unsigned char* lds;
    __device__ __forceinline__ void operator()(const f32x4 (&acc)[2][2][4][2], const Unit& u, int wr, int wc, int fr, int fq) const {
        PG8_LAS const float* R = stage_rstd((const float*)(ws + WS_PS), lds, u.pm);
#pragma unroll
        for (int ai = 0; ai < 2; ++ai)
#pragma unroll
            for (int m = 0; m < 4; ++m) {
                const int row = u.pm * BM + ai * HALF + wr * 64 + m * 16 + fr;
                const float rs = R[ai * HALF + wr * 64 + m * 16 + fr];
                bf16_t* ACT = (bf16_t*)(ws + WS_ACT);
                f32x4 a[2];
#pragma unroll
                for (int n = 0; n < 2; ++n) {
                    const f32x4 g = acc[ai][0][m][n] * rs, uu = acc[ai][1][m][n] * rs;
#pragma unroll
                    for (int j = 0; j < 4; ++j) a[n][j] = g[j] * __builtin_amdgcn_rcpf(1.0f + __builtin_amdgcn_exp2f(-1.4426950408889634f * g[j])) * uu[j];
                }
                *(u32x4*)(ACT + (size_t)row * 2816 + u.pn * 128 + wc * 32 + 8 * fq) = pack8(a[0], a[1]);
            }
    }
};


template <class Epi, class Sched, bool ALIGN_EPI = false, bool SP2 = false>
__device__ __forceinline__ void gemm_phase(PG8_LAS unsigned char* lds, const Gemm g, const Sched& S, const Epi& E) {
    int tid_ = threadIdx.x; asm volatile("" : "+v"(tid_));
    const int tid = tid_, wid = __builtin_amdgcn_readfirstlane(tid >> 6), lane = tid & 63, wr = wid >> 2, wc = wid & 3, fr = lane & 15, fq = lane >> 4;
    const int K = g.K, nt = K / BK;
    unsigned voffA[2], voffB[2];
#pragma unroll
    for (int i = 0; i < 2; ++i) { int R, C; stage_rc(tid * 16 + i * 8192, R, C); const int Rb = Epi::PERM ? ((R & ~31) + perm32(R & 31)) : R;
        voffA[i] = (unsigned)(R * K + C) * 2u; voffB[i] = (unsigned)(Rb * K + C) * 2u; }
    const size_t kstep = (size_t)(BK * 2);
    const size_t hstep = (size_t)HALF * K * 2;
    const size_t tstep = 2 * hstep;
    const unsigned ldsw = (unsigned)wid * 1024u;
    const int aoff = lds_byte(wr * 64 + fr, fq * 8), boff = lds_byte(wc * 32 + fr, fq * 8);
#define PG8_SA(b, h) (((b) * 2 + (h)) * HTB)
#define PG8_SB(b, h) ((4 + (b) * 2 + (h)) * HTB)
#define PG8_STAGE(bufoff, gbase, voff) do { _Pragma("unroll") for (int _i = 0; _i < 2; ++_i) \
        __builtin_amdgcn_global_load_lds((const unsigned*)((const char*)(gbase) + (voff)[_i]), (PG8_LAS unsigned*)(lds + (bufoff) + ldsw + _i * 8192), 16, 0, 0); } while (0)
#define PG8_LDA(dst, b, h) do { _Pragma("unroll") for (int m = 0; m < 4; ++m) _Pragma("unroll") for (int k = 0; k < 2; ++k) dst[m][k] = *(const PG8_LAS bf16x8*)(lds + PG8_SA(b, h) + aoff + m * 2048 + k * 1024); } while (0)
#define PG8_LDB(dst, b, h) do { _Pragma("unroll") for (int n = 0; n < 2; ++n) _Pragma("unroll") for (int k = 0; k < 2; ++k) dst[n][k] = *(const PG8_LAS bf16x8*)(lds + PG8_SB(b, h) + boff + n * 2048 + k * 1024); } while (0)
#define PG8_MMA(ai, bj, At, Bt) do { __builtin_amdgcn_s_setprio(1); _Pragma("unroll") for (int m = 0; m < 4; ++m) _Pragma("unroll") for (int n = 0; n < 2; ++n) _Pragma("unroll") for (int k = 0; k < 2; ++k) \
        acc[ai][bj][m][n] = __builtin_amdgcn_mfma_f32_16x16x32_bf16(Bt[n][k], At[m][k], acc[ai][bj][m][n], 0, 0, 0); __builtin_amdgcn_s_setprio(0); } while (0)
#define PG8_WAIT_V(n) asm volatile("s_waitcnt vmcnt(" #n ")" ::: "memory")
#define PG8_WAIT_L(n) asm volatile("s_waitcnt lgkmcnt(" #n ")" ::: "memory")
#define PG8_BAR __builtin_amdgcn_s_barrier()
#define PG8_SCHED __builtin_amdgcn_sched_barrier(0)
    Unit cur, nxt; int ui = 0;
    if (!S.next(0, cur)) return;
    f32x4 acc[2][2][4][2];
#pragma unroll
    for (int a = 0; a < 2; ++a)
#pragma unroll
        for (int b = 0; b < 2; ++b)
#pragma unroll
            for (int m = 0; m < 4; ++m)
#pragma unroll
                for (int n = 0; n < 2; ++n) acc[a][b][m][n] = (f32x4){0.f, 0.f, 0.f, 0.f};
    bf16x8 At[4][2], B0[2][2], B1[2][2];
    const char* cA = (const char*)g.A + (size_t)cur.pm * tstep; const char* cB = (const char*)g.Bt + (size_t)cur.pn * tstep;
    S.a_ready(cur);
    if constexpr (SP2) {
        PG8_STAGE(PG8_SB(0, 0), cB, voffB); PG8_STAGE(PG8_SB(0, 1), cB + hstep, voffB); PG8_STAGE(PG8_SA(0, 0), cA, voffA); PG8_STAGE(PG8_SA(0, 1), cA + hstep, voffA);
        if (wr == 1) PG8_BAR;
        PG8_WAIT_V(2); PG8_BAR;
        PG8_STAGE(PG8_SB(1, 0), cB + kstep, voffB); PG8_STAGE(PG8_SA(1, 0), cA + kstep, voffA); PG8_STAGE(PG8_SB(1, 1), cB + hstep + kstep, voffB);
        PG8_WAIT_V(6); PG8_BAR;
    } else {
        PG8_STAGE(PG8_SB(0, 0), cB, voffB); PG8_STAGE(PG8_SA(0, 0), cA, voffA); PG8_STAGE(PG8_SB(0, 1), cB + hstep, voffB); PG8_STAGE(PG8_SA(0, 1), cA + hstep, voffA);
        if (wr == 1) PG8_BAR;
        PG8_WAIT_V(4); PG8_BAR;
        PG8_STAGE(PG8_SB(1, 0), cB + kstep, voffB); PG8_STAGE(PG8_SA(1, 0), cA + kstep, voffA); PG8_STAGE(PG8_SB(1, 1), cB + hstep + kstep, voffB);
        PG8_WAIT_V(6); PG8_BAR;
    }
    for (;;) {
        const bool has_next = S.next(ui + 1, nxt);
        const char* nA = has_next ? (const char*)g.A + (size_t)nxt.pm * tstep : cA; const char* nB = has_next ? (const char*)g.Bt + (size_t)nxt.pn * tstep : cB;
        for (int t = 0; t < nt; t += 2) {
            const bool last = (t == nt - 2);
            const char* a1 = cA + (size_t)(t + 1) * kstep;
            const char* a2 = last ? nA : cA + (size_t)(t + 2) * kstep; const char* b2 = last ? nB : cB + (size_t)(t + 2) * kstep;
            const char* a3 = a2 + kstep; const char* b3 = b2 + kstep;
            if (last && has_next) S.a_ready(nxt);
            if constexpr (SP2) {
            PG8_LDB(B0, 0, 0); PG8_LDB(B1, 0, 1); PG8_SCHED; PG8_LDA(At, 0, 0); PG8_STAGE(PG8_SA(1, 1), a1 + hstep, voffA);
            PG8_WAIT_V(8); PG8_WAIT_L(0); PG8_BAR; PG8_MMA(0, 0, At, B0); PG8_MMA(0, 1, At, B1); PG8_BAR; PG8_SCHED;
            PG8_LDA(At, 0, 1); PG8_STAGE(PG8_SB(0, 0), b2, voffB); PG8_STAGE(PG8_SB(0, 1), b2 + hstep, voffB); PG8_STAGE(PG8_SA(0, 0), a2, voffA);
            PG8_WAIT_V(8); PG8_WAIT_L(0); PG8_BAR; PG8_MMA(1, 0, At, B0); PG8_MMA(1, 1, At, B1); PG8_BAR; PG8_SCHED;
            PG8_LDB(B0, 1, 0); PG8_LDB(B1, 1, 1); PG8_SCHED; PG8_LDA(At, 1, 0); PG8_STAGE(PG8_SA(0, 1), a2 + hstep, voffA);
            PG8_WAIT_V(8); PG8_WAIT_L(0); PG8_BAR; PG8_MMA(0, 0, At, B0); PG8_MMA(0, 1, At, B1); PG8_BAR; PG8_SCHED;
            PG8_LDA(At, 1, 1); PG8_STAGE(PG8_SB(1, 0), b3, voffB); PG8_STAGE(PG8_SB(1, 1), b3 + hstep, voffB); PG8_STAGE(PG8_SA(1, 0), a3, voffA);
            PG8_WAIT_V(8); PG8_WAIT_L(0); PG8_BAR; PG8_MMA(1, 0, At, B0); PG8_MMA(1, 1, At, B1); PG8_BAR; PG8_SCHED;
            } else {
            PG8_LDB(B0, 0, 0); PG8_SCHED; PG8_LDA(At, 0, 0); PG8_STAGE(PG8_SA(1, 1), a1 + hstep, voffA);
            PG8_WAIT_L(8); PG8_BAR; PG8_WAIT_L(0); PG8_MMA(0, 0, At, B0); PG8_BAR; PG8_SCHED;
            PG8_LDB(B1, 0, 1); PG8_STAGE(PG8_SB(0, 0), b2, voffB);
            PG8_BAR; PG8_WAIT_L(0); PG8_MMA(0, 1, At, B1); PG8_BAR;
            PG8_LDA(At, 0, 1); PG8_STAGE(PG8_SA(0, 0), a2, voffA);
            PG8_BAR; PG8_WAIT_L(0); PG8_MMA(1, 0, At, B0); PG8_BAR; PG8_SCHED;
            PG8_STAGE(PG8_SB(0, 1), b2 + hstep, voffB);
            PG8_WAIT_V(6); PG8_BAR; PG8_MMA(1, 1, At, B1); PG8_BAR;
            PG8_LDB(B0, 1, 0); PG8_SCHED; PG8_LDA(At, 1, 0); PG8_STAGE(PG8_SA(0, 1), a2 + hstep, voffA);
            PG8_WAIT_L(8); PG8_BAR; PG8_WAIT_L(0); PG8_MMA(0, 0, At, B0); PG8_BAR; PG8_SCHED;
            PG8_LDB(B1, 1, 1); PG8_STAGE(PG8_SB(1, 0), b3, voffB);
            PG8_BAR; PG8_WAIT_L(0); PG8_MMA(0, 1, At, B1); PG8_BAR;
            PG8_LDA(At, 1, 1); PG8_STAGE(PG8_SA(1, 0), a3, voffA);
            PG8_BAR; PG8_WAIT_L(0); PG8_MMA(1, 0, At, B0); PG8_BAR; PG8_SCHED;
            PG8_STAGE(PG8_SB(1, 1), b3 + hstep, voffB);
            PG8_WAIT_V(6); PG8_BAR; PG8_MMA(1, 1, At, B1); PG8_BAR;
            }
        }
        if constexpr (ALIGN_EPI) { if (wr == 0) PG8_BAR; }
        if constexpr (!Epi::AFTER_DRAIN) { E(acc, cur, wr, wc, fr, fq); S.done(cur); }
        if (!has_next) break;
#pragma unroll
        for (int a = 0; a < 2; ++a)
#pragma unroll
            for (int b = 0; b < 2; ++b)
#pragma unroll
                for (int m = 0; m < 4; ++m)
#pragma unroll
                    for (int n = 0; n < 2; ++n) acc[a][b][m][n] = (f32x4){0.f, 0.f, 0.f, 0.f};
        cur = nxt; cA = nA; cB = nB; ++ui;
        if constexpr (ALIGN_EPI) { if (wr == 1) PG8_BAR; }
    }
    PG8_WAIT_V(0);
    if constexpr (!ALIGN_EPI) { if (wr == 0) PG8_BAR; }
    PG8_BAR;
    if constexpr (Epi::AFTER_DRAIN) { E.fused(acc, cur, wr, wc, fr, fq, lds, wid, lane); S.done(cur); }
#undef PG8_SA
#undef PG8_SB
#undef PG8_STAGE
#undef PG8_LDA
#undef PG8_LDB
#undef PG8_MMA
#undef PG8_WAIT_V
#undef PG8_WAIT_L
#undef PG8_BAR
#undef PG8_SCHED
}
}
typedef unsigned short bf16;
#define XB_TMO      128
#define XB_XCNT(j)  (256  + 64 * (j))
#define XB_XSUB(j)  (1280 + 64 * (j))
#define XB_XGEN(j)  (2304 + 64 * (j))
#define XB_TOP      3328
#define XB_TOPGEN   3392
#define XCD_BAR_WORDS 3456
#define XB_SPIN_CAP (1u << 18)

__device__ __forceinline__ unsigned xb_ld(unsigned* p)              { return __hip_atomic_load(p, __ATOMIC_RELAXED, __HIP_MEMORY_SCOPE_AGENT); }
__device__ __forceinline__ unsigned xb_add(unsigned* p, unsigned v) { return __hip_atomic_fetch_add(p, v, __ATOMIC_RELAXED, __HIP_MEMORY_SCOPE_AGENT); }
__device__ __forceinline__ unsigned xb_xcc_id() { return (unsigned)__builtin_amdgcn_s_getreg((3 << 11) | 20) & 0xFu; }
#define XB_SPIN(cond, bar) do { unsigned _sp = 0; while (cond) { __builtin_amdgcn_s_sleep(1); \
    if ((++_sp & 255u) == 0u) { if (xb_ld(&(bar)[XB_TMO])) break; if (_sp > XB_SPIN_CAP) { atomicAdd(&(bar)[XB_TMO], 1u); break; } } } } while (0)

struct XcdBarrier {
    unsigned* bar; unsigned x;
    volatile LAS unsigned* st;
};

__device__ __forceinline__ XcdBarrier xcd_barrier_post(unsigned* bar, volatile LAS unsigned* st) {
    XcdBarrier b; b.bar = bar; b.x = xb_xcc_id(); b.st = st;
    if (threadIdx.x == 0) (void)xb_add(&bar[XB_XCNT(b.x)], 1u);
    return b;
}
__device__ __forceinline__ void xcd_barrier_complete(unsigned* bar, unsigned x, unsigned& nloc, unsigned& nx) {
    const unsigned G = gridDim.x * gridDim.y * gridDim.z;
    unsigned sum, cnt, mine, sp = 0u;
    for (;;) {
        sum = 0u; cnt = 0u; mine = 0u;
#pragma unroll
        for (unsigned j = 0; j < 16; ++j) { const unsigned c = xb_ld(&bar[XB_XCNT(j)]); sum += c; cnt += (c > 0u) ? 1u : 0u; mine = (j == x) ? c : mine; }
        if (sum == G) break;
        __builtin_amdgcn_s_sleep(1);
        if ((++sp & 255u) == 0u) { if (xb_ld(&bar[XB_TMO])) break; if (sp > XB_SPIN_CAP) { atomicAdd(&bar[XB_TMO], 1u); break; } }
    }
    nloc = mine > 0u ? mine : 1u; nx = cnt > 0u ? cnt : 1u;
}

__device__ __forceinline__ void xcd_barrier(const XcdBarrier& b) {
    asm volatile("s_waitcnt vmcnt(0)" ::: "memory");
    __syncthreads();
    if (threadIdx.x == 0) {
        unsigned* bar = b.bar;
        __builtin_amdgcn_s_waitcnt(0);
        unsigned nloc = b.st[0], nx = b.st[1];
        if (nloc == 0u) { xcd_barrier_complete(bar, b.x, nloc, nx); b.st[0] = nloc; b.st[1] = nx; }
        const unsigned old = xb_add(&bar[XB_XSUB(b.x)], 1u);
        const unsigned gen = old / nloc;
        if (old + 1u == (gen + 1u) * nloc) {
            __builtin_amdgcn_fence(__ATOMIC_RELEASE, "agent");
            asm volatile("s_waitcnt vmcnt(0)" ::: "memory");
            const unsigned og = xb_add(&bar[XB_TOP], 1u);
            const unsigned tg = og / nx;
            if (og + 1u == (tg + 1u) * nx) xb_add(&bar[XB_TOPGEN], 1u);
            else XB_SPIN(xb_ld(&bar[XB_TOPGEN]) == tg, bar);
            __builtin_amdgcn_fence(__ATOMIC_ACQUIRE, "agent");
            xb_add(&bar[XB_XGEN(b.x)], 1u);
            asm volatile("s_waitcnt vmcnt(0)" ::: "memory");
        } else {
            XB_SPIN(xb_ld(&bar[XB_XGEN(b.x)]) == gen, bar);
            __builtin_amdgcn_fence(__ATOMIC_ACQUIRE, "agent");
            asm volatile("s_waitcnt vmcnt(0)" ::: "memory");
        }
    }
    __syncthreads();
}

#define GAS __attribute__((address_space(1)))
#define LAS __attribute__((address_space(3)))
typedef unsigned short bf16;
typedef unsigned v4u __attribute__((ext_vector_type(4)));
typedef unsigned v2u __attribute__((ext_vector_type(2)));
typedef float f32x4 __attribute__((ext_vector_type(4)));
typedef short bf16x8 __attribute__((ext_vector_type(8)));
#define LDS_WAIT() asm volatile("s_waitcnt lgkmcnt(0)" ::: "memory")

constexpr int NWAVES = 8;
constexpr int D = 1024, NBP = 8, SEQ = 2048, DEPTH = 4, NBS = 32, DSEQ = 64;
constexpr int MP = NBP * SEQ, MS = NBS * DSEQ, MT = MP + MS;
constexpr int INW = 1792, DFF = 2816, NMEM = 256, UBW = 1408;
constexpr float EPS = 1e-6f, LOG2E = 1.4426950408889634f;
constexpr int NPHASE = 21;
constexpr int NUNITS = MT / 64;

constexpr int A_KS = 0, A_VT1 = 55296, A_VT2 = 73728, A_RED = 141312, MISC_OFF = 143360, LDS_BYTES = 147456;

struct Args { const float* in[23]; float* out; unsigned char* ws; int ph_lo, ph_hi; };

__device__ __forceinline__ float wave_sum(float v) {
#pragma unroll
    for (int o = 1; o < 64; o <<= 1) v += __shfl_xor(v, o);
    return v;
}
__device__ __forceinline__ unsigned pk2(float lo, float hi) { return pg8::cvt_pk_bf16(lo, hi); }

__device__ __forceinline__ void p0_transpose_item(const float* W, int ldw, int K, const float* gain, bf16* WT, int n0src, int n0dst, int k0, LAS float* scr, int lane) {
#pragma unroll
    for (int i = 0; i < 32; ++i) {
        const int kk = 2 * i + (lane >> 5);
        float w = __builtin_nontemporal_load(&W[(size_t)(k0 + kk) * ldw + n0src + (lane & 31)]);
        if (gain) w *= gain[k0 + kk];
        scr[kk * 33 + (lane & 31)] = w;
    }
    LDS_WAIT(); asm volatile("" ::: "memory");
    const int c = lane & 7;
#pragma unroll
    for (int j = 0; j < 4; ++j) {
        const int n = (lane >> 3) + 8 * j; const LAS float* s = scr + (8 * c) * 33 + n;
        v4u o; o.x = pk2(s[0 * 33], s[1 * 33]); o.y = pk2(s[2 * 33], s[3 * 33]); o.z = pk2(s[4 * 33], s[5 * 33]); o.w = pk2(s[6 * 33], s[7 * 33]);
        *(v4u*)(WT + (size_t)(n0dst + n) * K + k0 + 8 * c) = o;
    }
    LDS_WAIT(); asm volatile("" ::: "memory");
}
__device__ __forceinline__ int perm_in(int nd) {
    const int pn = nd >> 8, p = nd & 255, bj = p >> 7, wc = (p >> 5) & 3, i = p & 31;
    if (pn == 4 || pn == 5) return (bj ? 1280 : 1024) + (pn - 4) * 128 + wc * 32 + i;
    return pn * 256 + wc * 64 + bj * 32 + i;
}
__device__ __forceinline__ int perm_gu(int nd) { const int pn = nd >> 8, p = nd & 255; return (p < 128) ? pn * 128 + p : DFF + pn * 128 + (p - 128); }
__device__ __forceinline__ int perm_mem(int nd) { const int pn = nd >> 8, p = nd & 255, bj = p >> 7, wc = (p >> 5) & 3, i = p & 31; return pn * 256 + wc * 64 + bj * 32 + i; }

__device__ __forceinline__ void convert_layer_weights(const Args& a, unsigned char* ws, LAS float* scr, int l, int gw, int NGW, int lane, int which) {
    constexpr int C_IN = 896, C_OUT = 512, C_GU = 2816, C_DN = 1408;
    const int n_in = (which & 1) ? C_IN : 0, n_out = (which & 2) ? C_OUT : 0, n_gu = (which & 4) ? C_GU : 0, n_dn = (which & 8) ? C_DN : 0;
    for (int it = gw; it < n_in + n_out + n_gu + n_dn; it += NGW) {
        int r = it;
        if (r < n_in) { const int kb = r / 56, nb = r % 56; p0_transpose_item(a.in[9] + (size_t)l * D * INW, INW, D, a.in[8] + l * D, (bf16*)(ws + WS_WIN) + (size_t)l * INW * D, perm_in(32 * nb), 32 * nb, 64 * kb, scr, lane); continue; } r -= n_in;
        if (r < n_out) { const int kb = r / 32, nb = r % 32; p0_transpose_item(a.in[19] + (size_t)l * D * D, D, D, a.in[18] + l * D, (bf16*)(ws + WS_WOUT) + (size_t)l * D * D, 32 * nb, 32 * nb, 64 * kb, scr, lane); continue; } r -= n_out;
        if (r < n_gu) { const int kb = r / 176, nb = r % 176; p0_transpose_item(a.in[21] + (size_t)l * D * 2 * DFF, 2 * DFF, D, a.in[20] + l * D, (bf16*)(ws + WS_WGU) + (size_t)l * 2 * DFF * D, perm_gu(32 * nb), 32 * nb, 64 * kb, scr, lane); continue; } r -= n_gu;
        { const int kb = r / 32, nb = r % 32; p0_transpose_item(a.in[22] + (size_t)l * DFF * D, D, DFF, nullptr, (bf16*)(ws + WS_WDN) + (size_t)l * D * DFF, 32 * nb, 32 * nb, 64 * kb, scr, lane); }
    }
}
__device__ __forceinline__ void convert_layer_caches(const Args& a, unsigned char* ws, LAS float* scr, int l, int gw, int NGW, int gt, int NGT, int lane) {
    constexpr int C_CMV = 1024, C_CWV = 256;
    for (int it = gw; it < C_CMV + C_CWV; it += NGW) {
        int r = it;
        if (r < C_CMV) { const int b = r / 32, r2 = r % 32, kb = r2 / 8, nb = r2 % 8; p0_transpose_item(a.in[7] + (size_t)(l * NBS + b) * 65536, 256, 256, nullptr, (bf16*)(ws + WS_MVT) + (size_t)(l * 40 + 8 + b) * 65536, 32 * nb, 32 * nb, 64 * kb, scr, lane); continue; } r -= C_CMV;
        { const int b = r / 8, r2 = r % 8, kb = r2 / 4, nb = r2 % 4; p0_transpose_item(a.in[4] + (size_t)(l * NBS + b) * 16384, 128, 128, nullptr, (bf16*)(ws + WS_CWVT) + (size_t)(l * NBS + b) * 16384, 32 * nb, 32 * nb, 64 * kb, scr, lane); }
    }
    for (int i = gt; i < (524288 + 2097152) / 8; i += NGT) {
        const float* src; bf16* dst;
        if (i < 65536) { const size_t e = (size_t)l * 524288 + (size_t)i * 8; src = a.in[3] + e; dst = (bf16*)(ws + WS_CWK) + e; }
        else { const int e = (i - 65536) * 8, b = e >> 16, rem = e & 65535; src = a.in[6] + (size_t)(l * NBS + b) * 65536 + rem; dst = (bf16*)(ws + WS_MK) + (size_t)(l * 40 + 8 + b) * 65536 + rem; }
        const f32x4 x0 = __builtin_nontemporal_load((const f32x4*)src), x1 = __builtin_nontemporal_load((const f32x4*)(src + 4));
        v4u o; o.x = pk2(x0.x, x0.y); o.y = pk2(x0.z, x0.w); o.z = pk2(x1.x, x1.y); o.w = pk2(x1.z, x1.w);
        *(v4u*)dst = o;
    }
}
__device__ __forceinline__ void p0_prologue(const Args& a, unsigned char* ws, LAS unsigned char* lds, int tid_in, int lane_in, int wave) {
    int tid = tid_in, lane = lane_in; asm volatile("" : "+v"(tid), "+v"(lane));
    LAS float* scr = (LAS float*)(lds + wave * 16384);
    const int G = gridDim.x, gw = blockIdx.x * NWAVES + wave, NGW = G * NWAVES;
    convert_layer_weights(a, ws, scr, 0, gw, NGW, lane, 1);
    for (int it = gw; it < DEPTH * 256; it += NGW) {
        const int l = it >> 8, r = it & 255, kb = r / 16, nb = r % 16;
        p0_transpose_item(a.in[15] + (size_t)l * D * 512, 512, D, a.in[14] + l * D, (bf16*)(ws + WS_WMEM) + (size_t)l * 512 * D, perm_mem(32 * nb), 32 * nb, 64 * kb, scr, lane);
    }
    convert_layer_caches(a, ws, scr, 0, gw, NGW, blockIdx.x * (NWAVES * 64) + tid, G * NWAVES * 64, lane);
    for (int m0 = 2 * gw; m0 < MT + NBP * NMEM; m0 += 2 * NGW) {
        f32x4 v[2][4]; float s[2];
#pragma unroll
        for (int q = 0; q < 2; ++q) {
            const int m = m0 + q;
            const float* src = (m < MP) ? a.in[0] + (size_t)m * D : (m < MT ? a.in[1] + (size_t)(m - MP) * D : a.in[2] + (size_t)(m - MT) * D);
            const f32x4* xr = (const f32x4*)src + lane;
#pragma unroll
            for (int j = 0; j < 4; ++j) v[q][j] = __builtin_nontemporal_load(&xr[64 * j]);
        }
#pragma unroll
        for (int q = 0; q < 2; ++q) {
            const int m = m0 + q;
            bf16* dst = (m < MT) ? (bf16*)(ws + WS_AB) + (size_t)m * D : (bf16*)(ws + WS_MEMB) + (size_t)(m - MT) * D;
            float sq = 0.f;
#pragma unroll
            for (int j = 0; j < 4; ++j) sq += (v[q][j].x * v[q][j].x + v[q][j].y * v[q][j].y) + (v[q][j].z * v[q][j].z + v[q][j].w * v[q][j].w);
            s[q] = wave_sum(sq);
            v2u* o8 = (v2u*)dst + lane;
#pragma unroll
            for (int j = 0; j < 4; ++j) { v2u o; o.x = pk2(v[q][j].x, v[q][j].y); o.y = pk2(v[q][j].z, v[q][j].w); o8[64 * j] = o; }
            if (m < MT) { if (lane < 16) ((float*)(ws + WS_PS))[(size_t)m * 16 + lane] = (lane == 0) ? s[q] : 0.f; }
            else if (lane == 0) ((float*)(ws + WS_MRS))[m - MT] = 1.0f / sqrtf(s[q] * (1.0f / D) + EPS);
        }
    }
    if (blockIdx.x == 0) for (int i = tid; i < DEPTH * 256; i += NWAVES * 64) {
        const int l = i >> 8, k = (i >> 6) & 3, j = i & 63;
        const float* gp = (k == 0) ? a.in[10] : ((k == 1) ? a.in[11] : ((k == 2) ? a.in[16] : a.in[17]));
        ((float*)(ws + WS_GT))[i] = gp[l * 64 + j];
    }
    const int gt = blockIdx.x * (NWAVES * 64) + tid, NGT = G * NWAVES * 64;
}
__device__ __forceinline__ void copy_window_outputs(const Args& a, int gt, int NGT) {
    for (int i = gt; i < 2 * 128 * 2048; i += NGT) {
        const int t = i >> 18, r = i & 262143, lb = r >> 11, q = r & 2047;
        const float* src = (t ? a.in[4] : a.in[3]) + (size_t)lb * 16384 + 8192 + q * 4;
        float* dst = a.out + (t ? O_WVS : O_WKS) + (size_t)lb * 16384 + q * 4;
        __builtin_nontemporal_store(__builtin_nontemporal_load((const f32x4*)src), (f32x4*)dst);
    }
}

__device__ __forceinline__ f32x4 mfma16(bf16x8 a, bf16x8 b, f32x4 c) { return __builtin_amdgcn_mfma_f32_16x16x32_bf16(a, b, c, 0, 0, 0); }

template <int NKT, int VSTR, bool SINK>
__device__ __forceinline__ void attn_core(LAS const unsigned char* kb_, LAS const unsigned char* vb_, bf16x8 q0, bf16x8 q1, float sk, unsigned mskbits, int fr, f32x4 (&o)[4]) {
    f32x4 S[NKT];
    const int krow = ((fr >> 2) << 3) + (fr & 3);
#pragma unroll
    for (int kt = 0; kt < NKT; ++kt) {
        const int key = (kt >> 1) * 32 + ((kt & 1) << 2) + krow;
        LAS const unsigned char* kp = kb_ + key * 144;
        const bf16x8 a0 = *(LAS const bf16x8*)kp, a1 = *(LAS const bf16x8*)(kp + 64);
        const float bias = ((mskbits >> (kt >> 2)) & 1u) ? -1e30f : 0.f;
        f32x4 s = mfma16(a0, q0, (f32x4){bias, bias, bias, bias});
        s = mfma16(a1, q1, s);
        S[kt] = s;
    }
    float mx = S[0][0];
#pragma unroll
    for (int kt = 0; kt < NKT; ++kt) mx = fmaxf(fmaxf(mx, fmaxf(S[kt][0], S[kt][1])), fmaxf(S[kt][2], S[kt][3]));
    mx = fmaxf(mx, __shfl_xor(mx, 16)); mx = fmaxf(mx, __shfl_xor(mx, 32));
    if (SINK) mx = fmaxf(mx, sk);
    float sum = 0.f;
#pragma unroll
    for (int kt = 0; kt < NKT; ++kt)
#pragma unroll
        for (int r = 0; r < 4; ++r) { const float p = __builtin_amdgcn_exp2f(S[kt][r] - mx); S[kt][r] = p; sum += p; }
    sum += __shfl_xor(sum, 16); sum += __shfl_xor(sum, 32);
    if (SINK) sum += __builtin_amdgcn_exp2f(sk - mx);
    const float inv = 1.0f / sum;
    bf16x8 pf[NKT / 2];
#pragma unroll
    for (int kb = 0; kb < NKT / 2; ++kb) {
        v4u w; w.x = pk2(S[2 * kb][0], S[2 * kb][1]); w.y = pk2(S[2 * kb][2], S[2 * kb][3]); w.z = pk2(S[2 * kb + 1][0], S[2 * kb + 1][1]); w.w = pk2(S[2 * kb + 1][2], S[2 * kb + 1][3]);
        pf[kb] = __builtin_bit_cast(bf16x8, w);
    }
#pragma unroll
    for (int dt = 0; dt < 4; ++dt) {
        f32x4 acc = (f32x4){0.f, 0.f, 0.f, 0.f};
#pragma unroll
        for (int kb = 0; kb < NKT / 2; ++kb) {
            const bf16x8 vf = *(LAS const bf16x8*)(vb_ + dt * 16 * VSTR + kb * 64);
            acc = mfma16(vf, pf[kb], acc);
        }
        o[dt] = acc * inv;
    }
}
__device__ __forceinline__ void unpack8(const v4u w, float (&f)[8]) {
    f[0] = __uint_as_float(w.x << 16); f[1] = __uint_as_float(w.x & 0xffff0000u); f[2] = __uint_as_float(w.y << 16); f[3] = __uint_as_float(w.y & 0xffff0000u);
    f[4] = __uint_as_float(w.z << 16); f[5] = __uint_as_float(w.z & 0xffff0000u); f[6] = __uint_as_float(w.w << 16); f[7] = __uint_as_float(w.w & 0xffff0000u);
}

template <bool DO_SWA, bool DO_MEM>
__device__ __forceinline__ void attn_unit(const Args& a, unsigned char* ws, LAS unsigned char* lds, int l, int tid_in, int lane_in, int wave, int unit) {
    const bf16* UB = (const bf16*)(ws + WS_UB); const bf16* VTG = (const bf16*)(ws + WS_VTG);
    const bf16* CWK = (const bf16*)(ws + WS_CWK); const bf16* CWVT = (const bf16*)(ws + WS_CWVT);
    bf16* MIX = (bf16*)(ws + WS_MIX);
    const int qs = wave & 3, g = wave >> 2;
    LAS float* red_a = (LAS float*)(lds + A_RED); LAS float* red_m = red_a + 128;
    {
        int tid = tid_in, lane = lane_in;
        asm volatile("" : "+v"(tid), "+v"(lane));
        const int fr = lane & 15, fq = lane >> 4;
        const bool is_s = unit >= 256;
        const int bb = is_s ? 8 + (unit - 256) : (unit >> 5), c = is_s ? 0 : (unit & 31), sb = unit - 256;
        const int row0 = is_s ? MP + sb * 64 : bb * SEQ + c * 64;
        const bool first = is_s || c == 0;
        const size_t qrow = (size_t)row0 + qs * 16 + fr;
        unsigned zr = 0u; asm volatile("" : "+v"(zr));
        const v4u zero4 = (v4u){zr, zr, zr, zr};
        unsigned mskbits = 0u;
        v4u kst[6], vst[6];
        if constexpr (DO_SWA) {
            const bf16* ksrc[3]; const bf16* vsrc[3]; int kstr[3], vstr[3];
#pragma unroll
            for (int s = 0; s < 3; ++s) {
                if (is_s && s < 2) { ksrc[s] = CWK + ((size_t)(l * NBS + sb) * 128 + s * 64) * 128; kstr[s] = 128; vsrc[s] = CWVT + (size_t)(l * NBS + sb) * 16384 + s * 64; vstr[s] = 128; }
                else {
                    int cc = is_s ? 0 : c - 2 + s; if (cc < 0) { mskbits |= 1u << s; cc = 0; }
                    const int tok0 = is_s ? row0 : bb * SEQ + cc * 64;
                    ksrc[s] = UB + (size_t)tok0 * UBW + 512; kstr[s] = UBW; vsrc[s] = VTG + tok0; vstr[s] = MT;
                }
            }
#pragma unroll
            for (int i = 0; i < 6; ++i) {
                const int s = i >> 1, rem = tid + 512 * (i & 1);
                const bool mk = (mskbits >> s) & 1u;
                kst[i] = zero4; vst[i] = zero4;
                if (!mk) { kst[i] = __builtin_nontemporal_load((const v4u*)(ksrc[s] + (size_t)(rem >> 4) * kstr[s] + (rem & 15) * 8));
                           vst[i] = __builtin_nontemporal_load((const v4u*)(vsrc[s] + (size_t)(rem >> 3) * vstr[s] + (rem & 7) * 8)); }
            }
        }
        bf16x8 qsw[4][2], qmm[2][2];
        if constexpr (DO_SWA)
#pragma unroll
        for (int hh = 0; hh < 4; ++hh) { const bf16* qp = UB + qrow * UBW + (g * 4 + hh) * 64 + fq * 8; qsw[hh][0] = __builtin_nontemporal_load((const bf16x8*)qp); qsw[hh][1] = __builtin_nontemporal_load((const bf16x8*)(qp + 32)); }
        if constexpr (DO_MEM)
#pragma unroll
        for (int hp = 0; hp < 2; ++hp) { const bf16* qp = UB + qrow * UBW + 1152 + (hp * 2 + g) * 64 + fq * 8; qmm[hp][0] = __builtin_nontemporal_load((const bf16x8*)qp); qmm[hp][1] = __builtin_nontemporal_load((const bf16x8*)(qp + 32)); }
        const int cgp = tid & 31, tg = tid >> 5, ch = cgp * 8, t0 = tg * 4;
        v4u cu[6], ccb[4]; f32x4 cwv[6];
        if constexpr (DO_SWA) {
            const float* cw = a.in[13] + l * 768 + ch;
#pragma unroll
            for (int k = 0; k < 3; ++k) { cwv[2 * k] = *(const f32x4*)(cw + k * 256); cwv[2 * k + 1] = *(const f32x4*)(cw + k * 256 + 4); }
            const bf16* ub = UB + (size_t)(row0 + t0) * UBW;
#pragma unroll
            for (int r = 0; r < 6; ++r) {
                if (r >= 2 || tg > 0 || !first) cu[r] = __builtin_nontemporal_load((const v4u*)(ub + (ptrdiff_t)(r - 2) * UBW + 896 + ch));
                else if (is_s) { const float* sp = a.in[5] + (size_t)(l * NBS + sb) * 512 + r * 256 + ch; const f32x4 s0 = *(const f32x4*)sp, s1 = *(const f32x4*)(sp + 4);
                                 cu[r] = (v4u){pk2(s0[0], s0[1]), pk2(s0[2], s0[3]), pk2(s1[0], s1[1]), pk2(s1[2], s1[3])}; }
                else cu[r] = zero4;
            }
#pragma unroll
            for (int i = 0; i < 4; ++i) ccb[i] = __builtin_nontemporal_load((const v4u*)(ub + (size_t)i * UBW + 640 + ch));
        }
        __builtin_amdgcn_sched_barrier(0);
        if constexpr (DO_SWA) {
            float w0[8], w1[8], w2[8];
#pragma unroll
            for (int j = 0; j < 4; ++j) { w0[j] = cwv[0][j]; w0[4 + j] = cwv[1][j]; w1[j] = cwv[2][j]; w1[4 + j] = cwv[3][j]; w2[j] = cwv[4][j]; w2[4 + j] = cwv[5][j]; }
#pragma unroll
            for (int i = 0; i < 4; ++i) {
                float ua[8], ub_[8], uc[8], cbv[8], cy[8];
                unpack8(cu[i], ua); unpack8(cu[i + 1], ub_); unpack8(cu[i + 2], uc); unpack8(ccb[i], cbv);
                float ss = 0.f;
#pragma unroll
                for (int j = 0; j < 8; ++j) { const float y = ua[j] * w0[j] + ub_[j] * w1[j] + uc[j] * w2[j]; cy[j] = cbv[j] * y; ss += cy[j] * cy[j]; }
                ss += __shfl_xor(ss, 1); ss += __shfl_xor(ss, 2); ss += __shfl_xor(ss, 4); ss += __shfl_xor(ss, 8); ss += __shfl_xor(ss, 16);
                const float rs = 1.0f / sqrtf(ss * (1.0f / 256.0f) + EPS);
                v4u o; o.x = pk2(cy[0] * rs, cy[1] * rs); o.y = pk2(cy[2] * rs, cy[3] * rs); o.z = pk2(cy[4] * rs, cy[5] * rs); o.w = pk2(cy[6] * rs, cy[7] * rs);
                *(v4u*)(MIX + (size_t)(row0 + t0 + i) * D + 512 + ch) = o;
            }
        }
        if constexpr (DO_SWA)
#pragma unroll
        for (int i = 0; i < 6; ++i) {
            const int s = i >> 1, rem = tid + 512 * (i & 1);
            { const int key = rem >> 4, c16 = rem & 15; *(LAS v4u*)(lds + A_KS + ((c16 >> 3) * 192 + s * 64 + key) * 144 + (c16 & 7) * 16) = kst[i]; }
            { const int col = rem >> 3, kc = rem & 7; *(LAS v4u*)(lds + A_VT1 + col * 400 + (s * 64 + kc * 8) * 2) = vst[i]; }
        }
        const bf16* MKb = (const bf16*)(ws + WS_MK) + (size_t)(l * 40 + bb) * 65536;
        const bf16* MVTb = (const bf16*)(ws + WS_MVT) + (size_t)(l * 40 + bb) * 65536;
        v4u mkst[8], mvst[8];
        __builtin_amdgcn_sched_barrier(0);
        __syncthreads();
        v2u osv[4][4];
        if constexpr (DO_SWA) {
            float ssq = 0.f;
#pragma unroll
            for (int hh = 0; hh < 4; ++hh) {
                const int h = g * 4 + hh;
                const float sk = a.in[12][l * 8 + h] * LOG2E;
                f32x4 o[4];
                attn_core<12, 400, true>(lds + A_KS + g * 192 * 144 + fq * 16, lds + A_VT1 + (g * 64 + fr) * 400 + fq * 16, qsw[hh][0], qsw[hh][1], sk, mskbits, fr, o);
#pragma unroll
                for (int dt = 0; dt < 4; ++dt) { ssq += pg8::sq4(o[dt]); osv[hh][dt] = (v2u){pk2(o[dt][0], o[dt][1]), pk2(o[dt][2], o[dt][3])}; }
            }
            ssq = pg8::quad_sum(ssq);
            if (fq == 0) red_a[g * 64 + qs * 16 + fr] = ssq;
        }
        if constexpr (DO_MEM) {
#pragma unroll
            for (int i = 0; i < 8; ++i) {
                const int chn = tid + 512 * i;
                mkst[i] = *(const v4u*)(MKb + (size_t)(chn >> 4) * 256 + (chn & 15) * 8);
                mvst[i] = *(const v4u*)(MVTb + (size_t)(chn >> 5) * 256 + (chn & 31) * 8);
            }
        }
        __syncthreads();
        if constexpr (DO_MEM)
#pragma unroll
        for (int i = 0; i < 8; ++i) {
            const int chn = tid + 512 * i;
            { const int key = chn >> 4, c16 = chn & 15; *(LAS v4u*)(lds + A_KS + ((c16 >> 3) * 256 + key) * 144 + (c16 & 7) * 16) = mkst[i]; }
            { const int col = chn >> 5, kc = chn & 31; *(LAS v4u*)(lds + A_VT2 + col * 528 + kc * 16) = mvst[i]; }
        }
        if constexpr (DO_MEM)
#pragma unroll
        for (int i = 0; i < 8; ++i) {
            const int chn = tid + 512 * i;
            mkst[i] = *(const v4u*)(MKb + (size_t)(chn >> 4) * 256 + 128 + (chn & 15) * 8);
            mvst[i] = *(const v4u*)(MVTb + (size_t)(128 + (chn >> 5)) * 256 + (chn & 31) * 8);
        }
        __builtin_amdgcn_sched_barrier(0);
        if constexpr (DO_SWA) {
            const float tot = red_a[qs * 16 + fr] + red_a[64 + qs * 16 + fr];
            const float rs = 1.0f / sqrtf(tot * (1.0f / 512.0f) + EPS);
#pragma unroll
            for (int hh = 0; hh < 4; ++hh)
#pragma unroll
                for (int dt = 0; dt < 4; ++dt) {
                    const v2u p = osv[hh][dt];
                    v2u w; w.x = pk2(__uint_as_float(p.x << 16) * rs, __uint_as_float(p.x & 0xffff0000u) * rs); w.y = pk2(__uint_as_float(p.y << 16) * rs, __uint_as_float(p.y & 0xffff0000u) * rs);
                    *(v2u*)(MIX + qrow * D + (g * 4 + hh) * 64 + dt * 16 + 4 * fq) = w;
                }
        }
        __syncthreads();
        f32x4 omem[2][4];
        if constexpr (DO_MEM) attn_core<16, 528, false>(lds + A_KS + g * 256 * 144 + fq * 16, lds + A_VT2 + (g * 64 + fr) * 528 + fq * 16, qmm[0][0], qmm[0][1], 0.f, 0u, fr, omem[0]);
        __syncthreads();
        if constexpr (DO_MEM)
#pragma unroll
        for (int i = 0; i < 8; ++i) {
            const int chn = tid + 512 * i;
            { const int key = chn >> 4, c16 = chn & 15; *(LAS v4u*)(lds + A_KS + ((c16 >> 3) * 256 + key) * 144 + (c16 & 7) * 16) = mkst[i]; }
            { const int col = chn >> 5, kc = chn & 31; *(LAS v4u*)(lds + A_VT2 + col * 528 + kc * 16) = mvst[i]; }
        }
        __syncthreads();
        if constexpr (DO_MEM) {
            attn_core<16, 528, false>(lds + A_KS + g * 256 * 144 + fq * 16, lds + A_VT2 + (g * 64 + fr) * 528 + fq * 16, qmm[1][0], qmm[1][1], 0.f, 0u, fr, omem[1]);
            float ssq = 0.f;
#pragma unroll
            for (int hp = 0; hp < 2; ++hp)
#pragma unroll
                for (int dt = 0; dt < 4; ++dt) ssq += pg8::sq4(omem[hp][dt]);
            ssq = pg8::quad_sum(ssq);
            if (fq == 0) red_m[g * 64 + qs * 16 + fr] = ssq;
            __syncthreads();
            const float tot = red_m[qs * 16 + fr] + red_m[64 + qs * 16 + fr];
            const float rs = 1.0f / sqrtf(tot * (1.0f / 256.0f) + EPS);
#pragma unroll
            for (int hp = 0; hp < 2; ++hp)
#pragma unroll
                for (int dt = 0; dt < 4; ++dt) {
                    const f32x4 o = omem[hp][dt] * rs;
                    v2u w; w.x = pk2(o[0], o[1]); w.y = pk2(o[2], o[3]);
                    *(v2u*)(MIX + qrow * D + 768 + (hp * 2 + g) * 64 + dt * 16 + 4 * fq) = w;
                }
            __syncthreads();
        }
    }
}
__device__ __forceinline__ void attn_phase(const Args& a, unsigned char* ws, LAS unsigned char* lds, int l, int tid_in, int lane_in, int wave) {
    for (int unit0 = blockIdx.x; unit0 < NUNITS + 32; unit0 += gridDim.x) {
        if (unit0 < 256) attn_unit<true, true>(a, ws, lds, l, tid_in, lane_in, wave, (unit0 & 7) * 32 + (unit0 >> 3));
        else if (unit0 < 288) attn_unit<true, false>(a, ws, lds, l, tid_in, lane_in, wave, unit0);
        else attn_unit<false, true>(a, ws, lds, l, tid_in, lane_in, wave, unit0 - 32);
    }
}

__device__ __forceinline__ void small_gemm_res(LAS unsigned char* lds, const bf16* A, const bf16* Bt, int K, const float* base_s, float* out, bf16* AB, float* PS, int sm, int sn, int tid_in) {
    int tid = tid_in; asm volatile("" : "+v"(tid));
    const int lane = tid & 63, wave = __builtin_amdgcn_readfirstlane(tid >> 6), wr = wave >> 2, wc = wave & 3, fr = lane & 15, fq = lane >> 4;
    constexpr int A_OFF = 0, B_OFF = 8192, STAGE = 24576, NS = 4;
    const int row0 = MP + sm * 64, col0 = sn * 128;
    int R0, C0, R1, C1; pg8::stage_rc(tid * 16, R0, C0); pg8::stage_rc(tid * 16 + 8192, R1, C1);
    const char* ga = (const char*)(A + (size_t)(row0 + R0) * K + C0);
    const char* gb0 = (const char*)(Bt + (size_t)(col0 + R0) * K + C0);
    const char* gb1 = (const char*)(Bt + (size_t)(col0 + R1) * K + C1);
    const unsigned ldsw = (unsigned)wave * 1024u;
#define SG_ISSUE(t_) do { const int so_ = ((t_) & (NS - 1)) * STAGE; const size_t ko_ = (size_t)(t_) * 128; \
        __builtin_amdgcn_global_load_lds((const unsigned*)(ga + ko_), (LAS unsigned*)(lds + so_ + A_OFF + ldsw), 16, 0, 0); \
        __builtin_amdgcn_global_load_lds((const unsigned*)(gb0 + ko_), (LAS unsigned*)(lds + so_ + B_OFF + ldsw), 16, 0, 0); \
        __builtin_amdgcn_global_load_lds((const unsigned*)(gb1 + ko_), (LAS unsigned*)(lds + so_ + B_OFF + 8192 + ldsw), 16, 0, 0); } while (0)
    const int nt = K / 64;
    SG_ISSUE(0); SG_ISSUE(1); SG_ISSUE(2);
    f32x4 acc[2][2];
#pragma unroll
    for (int m_ = 0; m_ < 2; ++m_)
#pragma unroll
        for (int n = 0; n < 2; ++n) acc[m_][n] = (f32x4){0.f, 0.f, 0.f, 0.f};
    const int aoff = A_OFF + pg8::lds_byte(wr * 32 + fr, fq * 8), boff = B_OFF + pg8::lds_byte(wc * 32 + fr, fq * 8);
    for (int t = 0; t < nt; ++t) {
        if (t + 2 < nt) asm volatile("s_waitcnt vmcnt(6)" ::: "memory");
        else if (t + 1 < nt) asm volatile("s_waitcnt vmcnt(3)" ::: "memory");
        else asm volatile("s_waitcnt vmcnt(0)" ::: "memory");
        asm volatile("s_waitcnt lgkmcnt(0)" ::: "memory");
        __builtin_amdgcn_s_barrier();
        asm volatile("" ::: "memory");
        if (t + 3 < nt) SG_ISSUE(t + 3);
        const int cur = (t & (NS - 1)) * STAGE;
#pragma unroll
        for (int kk = 0; kk < 2; ++kk) {
            bf16x8 af[2], bfr[2];
#pragma unroll
            for (int i = 0; i < 2; ++i) { af[i] = *(LAS const bf16x8*)(lds + cur + aoff + i * 2048 + kk * 1024); bfr[i] = *(LAS const bf16x8*)(lds + cur + boff + i * 2048 + kk * 1024); }
#pragma unroll
            for (int m_ = 0; m_ < 2; ++m_)
#pragma unroll
                for (int n = 0; n < 2; ++n) acc[m_][n] = mfma16(bfr[n], af[m_], acc[m_][n]);
        }
    }
#undef SG_ISSUE
    asm volatile("s_waitcnt lgkmcnt(0)" ::: "memory");
    __builtin_amdgcn_s_barrier();
    asm volatile("" ::: "memory");
    constexpr int STAGE_END = NS * STAGE;
    LAS float* red = (LAS float*)(lds + STAGE_END);
    f32x4 bv[2][2];
#pragma unroll
    for (int m_ = 0; m_ < 2; ++m_)
#pragma unroll
        for (int n = 0; n < 2; ++n) bv[m_][n] = *(const f32x4*)(base_s + (size_t)(row0 + wr * 32 + m_ * 16 + fr - MP) * D + col0 + wc * 32 + n * 16 + 4 * fq);
#pragma unroll
    for (int m_ = 0; m_ < 2; ++m_) {
        const int rl = wr * 32 + m_ * 16 + fr, row = row0 + rl;
        float ss = 0.f;
#pragma unroll
        for (int n = 0; n < 2; ++n) {
            const int c = col0 + wc * 32 + n * 16 + 4 * fq;
            const f32x4 y = bv[m_][n] + acc[m_][n];
            *(f32x4*)(out + (size_t)row * D + c) = y;
            *(v2u*)(AB + (size_t)row * D + c) = (v2u){pk2(y[0], y[1]), pk2(y[2], y[3])};
            ss += pg8::sq4(y);
        }
        ss = pg8::quad_sum(ss);
        if (fq == 0) red[rl * 4 + wc] = ss;
    }
    __syncthreads();
    if (tid < 128) { const int r = tid >> 1, sl = tid & 1; PS[(size_t)(row0 + r) * 16 + sn * 2 + sl] = red[r * 4 + sl * 2] + red[r * 4 + sl * 2 + 1]; }
    __syncthreads();
}

#ifndef PROBE_MASK
#define PROBE_MASK 0
#endif
#ifndef PHMASK
#define PHMASK 127
#endif
#ifndef USE_CG_SYNC
#define USE_CG_SYNC 1
#endif
__global__ void __launch_bounds__(NWAVES * 64, 2) hymba_fwd(Args args) {
    extern __shared__ __attribute__((aligned(16))) unsigned char lds_raw[];
    LAS unsigned char* lds = (LAS unsigned char*)lds_raw;
    const int tid = threadIdx.x, lane = tid & 63, wave = __builtin_amdgcn_readfirstlane(tid >> 6);
    const int lo = args.ph_lo, hi = args.ph_hi;
    volatile LAS unsigned* MISC = (volatile LAS unsigned*)(lds + MISC_OFF);
    if (tid < 32) MISC[tid] = 0u;
    __syncthreads();
    XcdBarrier bar = xcd_barrier_post((unsigned*)(args.ws + WS_CTL) + CW_BAR, MISC + 8);
#if USE_CG_SYNC == 1
#define GRID_BAR(ph) cg::this_grid().sync()
#elif USE_CG_SYNC == 2
#define GRID_BAR(ph) do { if ((ph) == 0) cg::this_grid().sync(); else xcd_barrier(bar); } while (0)
#elif USE_CG_SYNC == 3
    if (lo < 0) cg::this_grid().sync();
#define GRID_BAR(ph) xcd_barrier(bar)
#else
#define GRID_BAR(ph) xcd_barrier(bar)
#endif
    const int G = gridDim.x;
    for (int ph = lo; ph < hi; ++ph) {
        size_t zoff = 0; asm volatile("" : "+s"(zoff));
        unsigned char* ws = args.ws + zoff;
        if (ph == 0) {
            if (PHMASK & 1) p0_prologue(args, ws, lds, tid, lane, wave);
#if PROBE_MASK & 1
            __syncthreads(); p0_prologue(args, ws, lds, tid, lane, wave);
#endif
        } else {
            const int l = (ph - 1) / 5, sub = (ph - 1) % 5;
            if (sub == 0) {
                if ((PHMASK & 2) && l == 0) {
                    pg8::Gemm gm{(const pg8::bf16_t*)(ws + WS_MEMB), (const pg8::bf16_t*)(ws + WS_WMEM), NBP * NMEM, DEPTH * 512, D};
                    pg8::StaticOrder S; S.init(NBP * NMEM, DEPTH * 512, G, (int)blockIdx.x);
                    pg8::EpiMem E{ws, args.out};
                    pg8::gemm_phase<pg8::EpiMem, pg8::StaticOrder, true, true>(lds, gm, S, E);
                }
                pg8::Gemm gm{(const pg8::bf16_t*)(ws + WS_AB), (const pg8::bf16_t*)(ws + WS_WIN) + (size_t)l * INW * D, MT, INW, D};
                pg8::StaticOrder S; S.init(MT, INW, G, (int)blockIdx.x);
                pg8::EpiIn E{ws, args.out, lds, l, 0};
                if (PHMASK & 4) pg8::gemm_phase<pg8::EpiIn, pg8::StaticOrder, true, true>(lds, gm, S, E);
                if (l == 0 && blockIdx.x >= 64) {
                    int ln = lane; asm volatile("" : "+v"(ln));
                    convert_layer_weights(args, ws, (LAS float*)(lds + wave * 16384), 0, ((int)blockIdx.x - 64) * NWAVES + wave, (G - 64) * NWAVES, ln, 14);
                }
            } else if (sub == 1) {
                if (PHMASK & 8) attn_phase(args, ws, lds, l, tid, lane, wave);
                if (l + 1 < DEPTH && blockIdx.x >= 64) {
                    int ln = lane; asm volatile("" : "+v"(ln));
                    convert_layer_weights(args, ws, (LAS float*)(lds + wave * 16384), l + 1, ((int)blockIdx.x - 64) * NWAVES + wave, (G - 64) * NWAVES, ln, 3);
                    if (l == 0) { int tn = tid; asm volatile("" : "+v"(tn)); copy_window_outputs(args, ((int)blockIdx.x - 64) * (NWAVES * 64) + tn, (G - 64) * NWAVES * 64); }
                }
#if PROBE_MASK & 2
                __syncthreads(); attn_phase(args, ws, lds, l, tid, lane, wave);
#endif
            } else if (sub == 2) {
                pg8::Gemm gm{(const pg8::bf16_t*)(ws + WS_MIX), (const pg8::bf16_t*)(ws + WS_WOUT) + (size_t)l * D * D, MT, D, D};
                pg8::StaticOrder S; S.init(MP, D, G, (int)blockIdx.x);
                pg8::EpiRes E{l == 0 ? args.in[0] : args.out + O_YP, l == 0 ? args.in[1] : args.out + O_YS, args.out, ws};
                if (PHMASK & 16) pg8::gemm_phase<pg8::EpiRes, pg8::StaticOrder, true, true>(lds, gm, S, E);
                for (int st = (int)blockIdx.x; st < 256; st += G)
                    small_gemm_res(lds, (const bf16*)(ws + WS_MIX), (const bf16*)(ws + WS_WOUT) + (size_t)l * D * D, D, l == 0 ? args.in[1] : args.out + O_YS, args.out, (bf16*)(ws + WS_AB), (float*)(ws + WS_PS), (st & 7) * 4 + ((st >> 3) & 3), st >> 5, tid);
            } else if (sub == 3) {
                pg8::Gemm gm{(const pg8::bf16_t*)(ws + WS_AB), (const pg8::bf16_t*)(ws + WS_WGU) + (size_t)l * 2 * DFF * D, MT, 2 * DFF, D};
                pg8::StaticOrder S; S.init(MT, 2 * DFF, G, (int)blockIdx.x);
                pg8::EpiGU E{ws, lds};
                if (PHMASK & 32) pg8::gemm_phase<pg8::EpiGU, pg8::StaticOrder, true, true>(lds, gm, S, E);
                if (l + 1 < DEPTH && blockIdx.x >= 48) {
                    int ln = lane, tn = tid; asm volatile("" : "+v"(ln), "+v"(tn));
                    const int wk = ((int)blockIdx.x - 48) * NWAVES + wave, nwk = (G - 48) * NWAVES;
                    convert_layer_weights(args, ws, (LAS float*)(lds + wave * 16384), l + 1, wk, nwk, ln, 12);
                    convert_layer_caches(args, ws, (LAS float*)(lds + wave * 16384), l + 1, wk, nwk, ((int)blockIdx.x - 48) * (NWAVES * 64) + tn, (G - 48) * NWAVES * 64, ln);
                }
#if PROBE_MASK & 4
                __syncthreads(); pg8::gemm_phase<pg8::EpiGU, pg8::StaticOrder, true, true>(lds, gm, S, E);
#endif
            } else {
                pg8::Gemm gm{(const pg8::bf16_t*)(ws + WS_ACT), (const pg8::bf16_t*)(ws + WS_WDN) + (size_t)l * D * DFF, MT, D, DFF};
                pg8::StaticOrder S; S.init(MP, D, G, (int)blockIdx.x);
                pg8::EpiRes E{args.out + O_YP, args.out + O_YS, args.out, ws};
                if (PHMASK & 64) pg8::gemm_phase<pg8::EpiRes, pg8::StaticOrder, true, true>(lds, gm, S, E);
                for (int st = (int)blockIdx.x; st < 256; st += G)
                    small_gemm_res(lds, (const bf16*)(ws + WS_ACT), (const bf16*)(ws + WS_WDN) + (size_t)l * D * DFF, DFF, args.out + O_YS, args.out, (bf16*)(ws + WS_AB), (float*)(ws + WS_PS), (st & 7) * 4 + ((st >> 3) & 3), st >> 5, tid);
            }
        }
        if (ph + 1 < hi) GRID_BAR(ph);
    }
}

#ifndef N_LAUNCH_MODE
#define N_LAUNCH_MODE 0
#endif
extern "C" void kernel_launch(void* const* d_in, const int* in_sizes, int n_in, void* d_out, int out_size, void* d_ws, size_t ws_size, hipStream_t stream) {
    static int grid = 0;
    if (grid == 0) {
        if (n_in != 23 || (size_t)out_size != O_END || ws_size < WS_END) { fprintf(stderr, "kernel_launch: unexpected shapes n_in %d out %d ws %zu\n", n_in, out_size, ws_size); grid = -1; return; }
        int dev = 0, cus = 0, per_cu = 0;
        if (hipGetDevice(&dev) != hipSuccess || hipDeviceGetAttribute(&cus, hipDeviceAttributeMultiprocessorCount, dev) != hipSuccess) { grid = -1; return; }
        if (hipFuncSetAttribute((const void*)hymba_fwd, hipFuncAttributeMaxDynamicSharedMemorySize, LDS_BYTES) != hipSuccess) { fprintf(stderr, "kernel_launch: hipFuncSetAttribute failed\n"); grid = -1; return; }
        if (hipOccupancyMaxActiveBlocksPerMultiprocessor(&per_cu, (const void*)hymba_fwd, NWAVES * 64, LDS_BYTES) != hipSuccess || per_cu < 1) { fprintf(stderr, "kernel_launch: occupancy query says %d\n", per_cu); per_cu = 1; }
        (void)hipGetLastError();
        grid = cus;
    }
    if (grid < 0) return;
    Args a{};
    for (int i = 0; i < 23; ++i) a.in[i] = (const float*)d_in[i];
    a.out = (float*)d_out; a.ws = (unsigned char*)d_ws;
#if N_LAUNCH_MODE == 0
    for (int ph = 0; ph < NPHASE; ++ph) {
        a.ph_lo = ph; a.ph_hi = ph + 1;
        hipLaunchKernelGGL(hymba_fwd, dim3(grid), dim3(NWAVES * 64), LDS_BYTES, stream, a);
    }
#else
    (void)hipMemsetAsync((char*)d_ws + WS_CTL, 0, CTL_ZERO_BYTES, stream);
    a.ph_lo = 0; a.ph_hi = NPHASE;
    void* kargs[] = {&a};
    hipError_t e = hipLaunchCooperativeKernel((const void*)hymba_fwd, dim3(grid), dim3(NWAVES * 64), kargs, LDS_BYTES, stream);
    if (e != hipSuccess) fprintf(stderr, "kernel_launch: cooperative launch failed: %s (grid %d)\n", hipGetErrorString(e), grid);
#endif
}
```
